# Optimizing an MI355X kernel written in HIP

```python
import math
import jax
import jax.numpy as jnp
from jax import lax
import numpy as np

D_MODEL = 1024
BATCH = 16
SEQ = 4096
DEPTH = 2
DEC_BATCH = 32
DEC_SEQ = 16
PAST_LEN = 2048

CHUNK = 64
GDN_HEADS = 4
GDN_DK = 128
GDN_DV = 128
CONV_W = 4
SWA_HEADS = 8
SWA_KV_HEADS = 2
SWA_GROUP = SWA_HEADS // SWA_KV_HEADS
SWA_HD = 64
WINDOW = 128
WIN_CHUNKS = WINDOW // CHUNK
N_MEM = 256
XA_HEADS = 4
XA_HD = 128
D_FF = 4 * D_MODEL
N_BRANCH = 3
BRANCH_W = 512
DN_ALPHA = (2.0 * DEPTH) ** 0.25
DN_BETA = (8.0 * DEPTH) ** -0.25
LN_EPS = 1e-5
NORM_EPS = 1e-6

GDN_QK = GDN_HEADS * GDN_DK
GDN_V = GDN_HEADS * GDN_DV
GDN_CONV_CH = 2 * GDN_QK + GDN_V
SWA_Q = SWA_HEADS * SWA_HD
SWA_KV = SWA_KV_HEADS * SWA_HD
XA_Q = XA_HEADS * XA_HD
IN_SPLITS = (GDN_CONV_CH, GDN_HEADS, GDN_HEADS, GDN_V, SWA_Q, SWA_KV, SWA_KV, XA_Q, N_BRANCH * D_MODEL)
D_IN = sum(IN_SPLITS)

kernel_name = 'hybrid_gdn_swa_memxattn_stream_step'


def layer_norm(x, g, b):
    xf = x.astype(jnp.float32)
    mu = jnp.mean(xf, axis=-1, keepdims=True)
    var = jnp.mean(jnp.square(xf - mu), axis=-1, keepdims=True)
    y = (xf - mu) * lax.rsqrt(var + LN_EPS) * g.astype(jnp.float32) + b.astype(jnp.float32)
    return y.astype(x.dtype)


def l2_normalize(x):
    return x * lax.rsqrt(jnp.sum(jnp.square(x), axis=-1, keepdims=True) + NORM_EPS)


def split_in(h):
    offsets = np.cumsum(IN_SPLITS)[:-1].tolist()
    return jnp.split(h, offsets, axis=-1)


def gated_delta_chunked(q, k, v, g, beta, s0):
    B, T, H, DK = q.shape
    DV = v.shape[-1]
    C = min(CHUNK, T)
    N = T // C

    def chunks(t):
        return jnp.transpose(t.reshape(B, N, C, H, t.shape[-1]), (1, 0, 3, 2, 4))

    qc, kc, vc = chunks(q), chunks(k), chunks(v)
    gc = jnp.cumsum(chunks(g[..., None])[..., 0], axis=-1)
    bc = chunks(beta[..., None])
    causal = jnp.tril(jnp.ones((C, C), dtype=bool))
    strict = jnp.tril(jnp.ones((C, C), dtype=bool), -1)
    decay = jnp.exp(jnp.where(causal, gc[..., :, None] - gc[..., None, :], -jnp.inf))
    kb = kc * bc
    a_mat = jnp.where(strict, jnp.einsum('nbhid,nbhjd->nbhij', kb, kc) * decay, 0.0) + jnp.eye(C, dtype=jnp.float32)
    u = lax.linalg.triangular_solve(a_mat, vc * bc, left_side=True, lower=True, unit_diagonal=True)
    w = lax.linalg.triangular_solve(a_mat, kb * jnp.exp(gc)[..., None], left_side=True, lower=True, unit_diagonal=True)
    qk = jnp.einsum('nbhid,nbhjd->nbhij', qc, kc) * decay

    def step(s, inp):
        q_i, k_i, u_i, w_i, qk_i, g_i = inp
        v_new = u_i - jnp.einsum('bhcd,bhde->bhce', w_i, s)
        o_i = (jnp.einsum('bhcd,bhde->bhce', q_i * jnp.exp(g_i)[..., None], s)
               + jnp.einsum('bhij,bhje->bhie', qk_i, v_new))
        g_last = g_i[..., -1:]
        s = (s * jnp.exp(g_last)[..., None]
             + jnp.einsum('bhcd,bhce->bhde', k_i * jnp.exp(g_last - g_i)[..., None], v_new))
        return s, o_i

    s_final, o = lax.scan(step, s0, (qc, kc, u, w, qk, gc))
    o = jnp.transpose(o, (1, 0, 3, 2, 4)).reshape(B, T, H, DV)
    return o, s_final


def gdn_branch(qkv, a, b, z, conv_buf, s0, conv_w, a_log, dt_bias, norm_w):
    B, T, _ = qkv.shape
    xin = jnp.concatenate([conv_buf.astype(qkv.dtype), qkv], axis=1)
    conv = lax.conv_general_dilated(xin, conv_w.astype(xin.dtype)[:, None, :], window_strides=(1,), padding='VALID',
                                    dimension_numbers=('NWC', 'WIO', 'NWC'), feature_group_count=GDN_CONV_CH)
    conv = jax.nn.silu(conv.astype(jnp.float32))
    q, k, v = jnp.split(conv, [GDN_QK, 2 * GDN_QK], axis=-1)
    q = l2_normalize(q.reshape(B, T, GDN_HEADS, GDN_DK)) * (GDN_DK ** -0.5)
    k = l2_normalize(k.reshape(B, T, GDN_HEADS, GDN_DK))
    v = v.reshape(B, T, GDN_HEADS, GDN_DV)
    g = -jnp.exp(a_log.astype(jnp.float32)) * jax.nn.softplus(a.astype(jnp.float32) + dt_bias.astype(jnp.float32))
    beta = jax.nn.sigmoid(b.astype(jnp.float32))
    o, s_final = gated_delta_chunked(q, k, v, g, beta, s0.astype(jnp.float32))
    o = o * lax.rsqrt(jnp.mean(jnp.square(o), axis=-1, keepdims=True) + NORM_EPS) * norm_w.astype(jnp.float32)
    o = o * jax.nn.silu(z.reshape(B, T, GDN_HEADS, GDN_DV).astype(jnp.float32))
    return o.reshape(B, T, GDN_V).astype(qkv.dtype), xin[:, -(CONV_W - 1):], s_final.astype(qkv.dtype)


def sink_attention(q, k, v, valid, sinks):
    s = jnp.einsum('...qkgd,...skd->...kgqs', q, k, preferred_element_type=jnp.float32) * (SWA_HD ** -0.5)
    s = jnp.where(valid, s, -jnp.inf)
    sink = jnp.broadcast_to(sinks.astype(jnp.float32).reshape(SWA_KV_HEADS, SWA_GROUP, 1, 1), s.shape[:-1] + (1,))
    p = jax.nn.softmax(jnp.concatenate([s, sink], axis=-1), axis=-1)[..., :-1]
    return jnp.einsum('...kgqs,...skd->...qkgd', p.astype(v.dtype), v)


def swa_prompt(q, k, v, sinks):
    B, T = q.shape[0], q.shape[1]
    nc = T // CHUNK
    pad = ((0, 0), (WIN_CHUNKS * CHUNK, 0), (0, 0), (0, 0))

    def band(t):
        tp = jnp.pad(t, pad).reshape(B, nc + WIN_CHUNKS, CHUNK, SWA_KV_HEADS, SWA_HD)
        return jnp.concatenate([tp[:, j:j + nc] for j in range(WIN_CHUNKS + 1)], axis=2)

    kb, vb = band(k), band(v)
    qb = q.reshape(B, nc, CHUNK, SWA_KV_HEADS, SWA_GROUP, SWA_HD)
    key_chunk = jnp.arange(nc)[:, None] - WIN_CHUNKS + jnp.arange((WIN_CHUNKS + 1) * CHUNK)[None, :] // CHUNK
    valid = (key_chunk >= 0)[:, None, None, None, :]
    o = sink_attention(qb, kb, vb, valid, sinks)
    return o.reshape(B, T, SWA_Q)


def swa_sample(q, k, v, ck, cv, sinks):
    B, T = q.shape[0], q.shape[1]
    n_keep = ck.shape[1]
    kk = jnp.concatenate([ck.astype(k.dtype), k], axis=1)
    vv = jnp.concatenate([cv.astype(v.dtype), v], axis=1)
    q_pos = PAST_LEN + jnp.arange(T)
    k_pos = jnp.concatenate([PAST_LEN - n_keep + jnp.arange(n_keep), q_pos])
    qc = (q_pos // CHUNK)[:, None]
    kc = (k_pos // CHUNK)[None, :]
    valid = (kc <= qc) & (kc >= qc - WIN_CHUNKS)
    o = sink_attention(q, kk, vv, valid, sinks)
    return o.reshape(B, T, SWA_Q), kk[:, -n_keep:], vv[:, -n_keep:]


def mem_kv(mem, w):
    B, M, _ = mem.shape
    mk, mv = jnp.split(mem @ w, 2, axis=-1)
    return mk.reshape(B, M, XA_HEADS, XA_HD), mv.reshape(B, M, XA_HEADS, XA_HD)


def mem_attention(q, mk, mv):
    B, T = q.shape[0], q.shape[1]
    s = jnp.einsum('bthd,bshd->bhts', q, mk.astype(q.dtype), preferred_element_type=jnp.float32) * (XA_HD ** -0.5)
    p = jax.nn.softmax(s, axis=-1)
    o = jnp.einsum('bhts,bshd->bthd', p.astype(q.dtype), mv.astype(q.dtype))
    return o.reshape(B, T, XA_Q)


def merge_and_channel_mix(x, branches, gate_pre, w_branch, w_o, ln1_g, ln1_b, w_up, w_down, ln2_g, ln2_b):
    gates = jnp.split(jax.nn.sigmoid(gate_pre.astype(jnp.float32)).astype(x.dtype), N_BRANCH, axis=-1)
    merged = gates[0] * (branches[0] @ w_branch[0])
    for i in range(1, N_BRANCH):
        merged = merged + gates[i] * (branches[i] @ w_branch[i])
    x = layer_norm(DN_ALPHA * x + merged @ w_o, ln1_g, ln1_b)
    hidden = jnp.square(jax.nn.relu(x @ w_up))
    return layer_norm(DN_ALPHA * x + hidden @ w_down, ln2_g, ln2_b)


def setup_inputs(seed: int = 0) -> dict:
    key = jax.random.key(seed)
    ks = jax.random.split(key, 24)
    f32 = jnp.float32
    n_keep = min(WINDOW, PAST_LEN)

    def nrm(k, shape, scale=1.0):
        return jax.random.normal(k, shape, f32) * scale

    dt = jnp.exp(jax.random.uniform(ks[10], (DEPTH, GDN_HEADS), f32, minval=math.log(1e-3), maxval=math.log(1e-1)))
    return {
        'x_prompt': nrm(ks[0], (BATCH, SEQ, D_MODEL)),
        'x_sample': nrm(ks[1], (DEC_BATCH, DEC_SEQ, D_MODEL)),
        'state_gdn_s': nrm(ks[2], (DEPTH, DEC_BATCH, GDN_HEADS, GDN_DK, GDN_DV), 0.5),
        'state_gdn_conv': nrm(ks[3], (DEPTH, DEC_BATCH, CONV_W - 1, GDN_CONV_CH)),
        'cache_swa_k': nrm(ks[4], (DEPTH, DEC_BATCH, n_keep, SWA_KV_HEADS, SWA_HD)),
        'cache_swa_v': nrm(ks[5], (DEPTH, DEC_BATCH, n_keep, SWA_KV_HEADS, SWA_HD)),
        'cache_mem_k': nrm(ks[6], (DEPTH, DEC_BATCH, N_MEM, XA_HEADS, XA_HD)),
        'cache_mem_v': nrm(ks[7], (DEPTH, DEC_BATCH, N_MEM, XA_HEADS, XA_HD)),
        'mem_prompt': nrm(ks[8], (BATCH, N_MEM, D_MODEL)),
        'w_in': nrm(ks[9], (DEPTH, D_MODEL, D_IN), D_MODEL ** -0.5),
        'conv_w': nrm(ks[11], (DEPTH, CONV_W, GDN_CONV_CH), CONV_W ** -0.5),
        'a_log': jnp.log(jax.random.uniform(ks[12], (DEPTH, GDN_HEADS), f32, minval=1.0, maxval=16.0)),
        'dt_bias': dt + jnp.log(-jnp.expm1(-dt)),
        'gdn_norm_w': 1.0 + nrm(ks[13], (DEPTH, GDN_DV), 0.02),
        'attn_sinks': nrm(ks[14], (DEPTH, SWA_HEADS), 0.5),
        'w_mem_kv': nrm(ks[15], (DEPTH, D_MODEL, 2 * XA_Q), D_MODEL ** -0.5),
        'w_branch': nrm(ks[16], (DEPTH, N_BRANCH, BRANCH_W, D_MODEL), BRANCH_W ** -0.5),
        'w_o': nrm(ks[17], (DEPTH, D_MODEL, D_MODEL), DN_BETA * D_MODEL ** -0.5),
        'ln1_g': 1.0 + nrm(ks[18], (DEPTH, D_MODEL), 0.02),
        'ln1_b': nrm(ks[19], (DEPTH, D_MODEL), 0.02),
        'w_up': nrm(ks[20], (DEPTH, D_MODEL, D_FF), D_MODEL ** -0.5),
        'w_down': nrm(ks[21], (DEPTH, D_FF, D_MODEL), DN_BETA * D_FF ** -0.5),
        'ln2_g': 1.0 + nrm(ks[22], (DEPTH, D_MODEL), 0.02),
        'ln2_b': nrm(ks[23], (DEPTH, D_MODEL), 0.02),
    }


def reference(x_prompt, x_sample, state_gdn_s, state_gdn_conv, cache_swa_k, cache_swa_v, cache_mem_k, cache_mem_v,
              mem_prompt, w_in, conv_w, a_log, dt_bias, gdn_norm_w, attn_sinks, w_mem_kv, w_branch, w_o,
              ln1_g, ln1_b, w_up, w_down, ln2_g, ln2_b):
    n_keep = cache_swa_k.shape[2]

    x = x_prompt
    B, T, _ = x.shape
    p_s, p_conv, p_k, p_v, p_mk, p_mv = [], [], [], [], [], []
    for l in range(DEPTH):
        qkv, a, b, z, q_s, k_s, v_s, q_x, gate_pre = split_in(x @ w_in[l])
        conv0 = jnp.zeros((B, CONV_W - 1, GDN_CONV_CH), x.dtype)
        s0 = jnp.zeros((B, GDN_HEADS, GDN_DK, GDN_DV), jnp.float32)
        o_g, conv_new, s_new = gdn_branch(qkv, a, b, z, conv0, s0, conv_w[l], a_log[l], dt_bias[l], gdn_norm_w[l])
        k_s = k_s.reshape(B, T, SWA_KV_HEADS, SWA_HD)
        v_s = v_s.reshape(B, T, SWA_KV_HEADS, SWA_HD)
        o_s = swa_prompt(q_s.reshape(B, T, SWA_KV_HEADS, SWA_GROUP, SWA_HD), k_s, v_s, attn_sinks[l])
        mk, mv = mem_kv(mem_prompt, w_mem_kv[l])
        o_x = mem_attention(q_x.reshape(B, T, XA_HEADS, XA_HD), mk, mv)
        x = merge_and_channel_mix(x, (o_g, o_s, o_x), gate_pre, w_branch[l], w_o[l], ln1_g[l], ln1_b[l],
                                  w_up[l], w_down[l], ln2_g[l], ln2_b[l])
        p_s.append(s_new)
        p_conv.append(conv_new)
        p_k.append(k_s[:, T - n_keep:])
        p_v.append(v_s[:, T - n_keep:])
        p_mk.append(mk)
        p_mv.append(mv)
    y_prompt = x

    x = x_sample
    B, T, _ = x.shape
    s_s, s_conv, s_k, s_v = [], [], [], []
    for l in range(DEPTH):
        qkv, a, b, z, q_s, k_s, v_s, q_x, gate_pre = split_in(x @ w_in[l])
        o_g, conv_new, s_new = gdn_branch(qkv, a, b, z, state_gdn_conv[l], state_gdn_s[l], conv_w[l], a_log[l],
                                          dt_bias[l], gdn_norm_w[l])
        o_s, k_buf, v_buf = swa_sample(q_s.reshape(B, T, SWA_KV_HEADS, SWA_GROUP, SWA_HD),
                                       k_s.reshape(B, T, SWA_KV_HEADS, SWA_HD), v_s.reshape(B, T, SWA_KV_HEADS, SWA_HD),
                                       cache_swa_k[l], cache_swa_v[l], attn_sinks[l])
        o_x = mem_attention(q_x.reshape(B, T, XA_HEADS, XA_HD), cache_mem_k[l], cache_mem_v[l])
        x = merge_and_channel_mix(x, (o_g, o_s, o_x), gate_pre, w_branch[l], w_o[l], ln1_g[l], ln1_b[l],
                                  w_up[l], w_down[l], ln2_g[l], ln2_b[l])
        s_s.append(s_new)
        s_conv.append(conv_new)
        s_k.append(k_buf)
        s_v.append(v_buf)
    y_sample = x

    return (y_prompt, y_sample,
            jnp.stack(p_s), jnp.stack(p_conv), jnp.stack(p_k), jnp.stack(p_v), jnp.stack(p_mk), jnp.stack(p_mv),
            jnp.stack(s_s), jnp.stack(s_conv), jnp.stack(s_k), jnp.stack(s_v))
```

```cpp
#include <hip/hip_runtime.h>
#include <hip/hip_cooperative_groups.h>
#include <cstdio>
namespace cg = cooperative_groups;

#define LAS __attribute__((address_space(3)))
#define DI __device__ __forceinline__
typedef unsigned short bf16_t;
typedef short bf16x8 __attribute__((ext_vector_type(8)));
typedef float f32x4 __attribute__((ext_vector_type(4)));
typedef float f32x2 __attribute__((ext_vector_type(2)));
typedef unsigned u32x4 __attribute__((ext_vector_type(4)));
typedef unsigned u32x2 __attribute__((ext_vector_type(2)));
typedef __bf16 bfv2 __attribute__((ext_vector_type(2)));

constexpr int NP = 65536, NS = 512, MT = NP + NS;
constexpr int DM = 1024, HLD = 3584, DFF = 4096, DIN = 6408;
constexpr int C_GQ = 0, C_GK = 512, C_GV = 1024, C_Z = 1536, C_SQ = 2048, C_SK = 2560, C_SV = 2688, C_XQ = 2816, C_A = 3328, C_B = 3332;
constexpr float DN_ALPHA = 1.41421356237f;
constexpr int NTHR = 512;
constexpr int LDS_BYTES = 147456;

constexpr size_t MiB = 1u << 20;
constexpr size_t WS_CTL = 0;
constexpr size_t WS_W = 1 * MiB, WL_BYTES = 36 * MiB;
constexpr size_t WO_IN = 0, WO_G = 7 * MiB, WO_BR = 13 * MiB, WO_O = 16 * MiB, WO_UP = 18 * MiB, WO_DN = 26 * MiB, WO_MKV = 34 * MiB;
constexpr size_t WS_MEMB = 73 * MiB;
constexpr size_t WS_MKV = 81 * MiB, MKV_L = 24 * MiB;
constexpr size_t WS_SWC = 129 * MiB, SWC_L = 2 * MiB;
constexpr size_t WS_XB = 133 * MiB;
constexpr size_t WS_H = 262 * MiB;
constexpr size_t WS_G = 714 * MiB;
constexpr size_t GP_ITEM = 73728;
constexpr int N_GITEMS = (1024 + 32) * 4;
constexpr size_t WS_EG = 1011 * MiB;
constexpr size_t WS_MERGED = 714 * MiB, WS_GS = 843 * MiB, WS_MS = 875 * MiB;
constexpr size_t WS_HID = 262 * MiB;
constexpr size_t WS_GT2S = 1012 * MiB;
constexpr size_t WS_SPM = 1013 * MiB;
constexpr size_t WS_SP = 843 * MiB;
constexpr int LDS_STATS = 131072;
constexpr size_t WS_NEED = 1020 * MiB;

constexpr size_t O_Y = 0, O_PGS = 67633152, O_PGC = 69730304, O_PSK = 69877760, O_PSV = 70402048, O_PMK = 70926336, O_PMV = 75120640,
                 O_SGS = 79314944, O_SGC = 83509248, O_SSK = 83804160, O_SSV = 84852736;

struct Params { const float* in[24]; float* out; unsigned char* ws; int ph_lo, ph_hi; };

struct Ctx {
    const float *xp, *xs, *st_s, *st_conv, *csk, *csv, *cmk, *cmv, *memp, *w_in, *conv_w, *a_log, *dt_bias, *gnw, *sinks, *w_mkv, *w_br, *w_o,
        *ln1g, *ln1b, *w_up, *w_dn, *ln2g, *ln2b;
    float* out; unsigned char* ws;
    int G, c, panel;
};

DI unsigned pk(float a, float b) { f32x2 v = {a, b}; bfv2 r = __builtin_convertvector(v, bfv2); return __builtin_bit_cast(unsigned, r); }
DI bf16_t f2bf(float a) { return (bf16_t)(pk(a, 0.f) & 0xffffu); }
DI float bf2f(bf16_t b) { return __uint_as_float(((unsigned)b) << 16); }
DI float bflo(unsigned w) { return __uint_as_float(w << 16); }
DI float bfhi(unsigned w) { return __uint_as_float(w & 0xffff0000u); }
DI f32x4 mfma16(bf16x8 a, bf16x8 b, f32x4 c) { return __builtin_amdgcn_mfma_f32_16x16x32_bf16(a, b, c, 0, 0, 0); }
DI bf16x8 mk8(unsigned a, unsigned b, unsigned c, unsigned d) { u32x4 v = {a, b, c, d}; return __builtin_bit_cast(bf16x8, v); }
DI float sigmoidf_(float x) { return __builtin_amdgcn_rcpf(1.f + __expf(-x)); }

constexpr int BM = 256, BK = 64, HALF = 128, HTB = HALF * BK * 2, NXCD = 8, WGM = 8;
DI int lds_byte(int r, int c) { const int st = (r >> 4) * 2 + (c >> 5), rr = r & 15, cc = c & 31, ob = rr * 64 + cc * 2; return st * 1024 + (ob ^ (((ob >> 9) & 1) << 5)); }
DI void stage_rc(int b, int& R, int& C) { const int st = b / 1024, sb = b % 1024, swz = sb ^ (((sb >> 9) & 1) << 5); R = (st >> 1) * 16 + swz / 64; C = (st & 1) * 32 + (swz % 64) / 2; }
DI int perm32(int rho) { const int n = rho >> 4, i = rho & 15; return 8 * (i >> 2) + 4 * n + (i & 3); }

enum { K_H = 0, K_MKV = 1, K_GATE = 2, K_BR = 3, K_RES = 4, K_UP = 5, K_PART = 6, K_GATE2 = 7, K_BRP = 8 };
enum { PH_H = 0, PH_MERGE = 1, PH_WO = 2, PH_UP = 3, PH_DN = 4, PH_MKV = 5, PH_WOS = 6, PH_DNS = 7, PH_GATE = 8, PH_MERGES = 9 };
struct UD { const char* A; const char* B; unsigned lda2, ldb2; int nt, kind, pm, pn, aux; };

DI void tile_map(int L, int nM, int nN, int& pm, int& pn) {
    const int nwg = nM * nN; int wgid = L;
    { const int q = nwg / NXCD, r = nwg % NXCD, xcd = wgid % NXCD, off = wgid / NXCD; wgid = (xcd < r ? xcd * (q + 1) : r * (q + 1) + (xcd - r) * q) + off; }
    const int nig = WGM * nN, gid = wgid / nig, fm = gid * WGM, gsz = (nM - fm) < WGM ? (nM - fm) : WGM;
    pm = fm + ((wgid % nig) % gsz); pn = (wgid % nig) / gsz;
}

template <int PH> DI bool get_unit(const Ctx& C, int layer, int i, UD& u) {
    const char* ws = (const char*)C.ws; const char* wl = ws + WS_W + (size_t)layer * WL_BYTES;
    constexpr int NRT = MT / 256;
    if (PH == PH_H) {
        const int L = i * C.G + C.c; if (L >= NRT * 14) return false;
        tile_map(L, NRT, 14, u.pm, u.pn); u.A = ws + WS_XB + (size_t)u.pm * 256 * 2048; u.B = wl + WO_IN + (size_t)u.pn * 256 * 2048; u.lda2 = 2048; u.ldb2 = 2048; u.nt = 16; u.kind = K_H; u.aux = 0; return true;
    } else if (PH == PH_MKV) {
        const int L = i * C.G + ((C.c - 28 + C.G) % C.G); if (L >= 64) return false;
        tile_map(L, 16, 4, u.pm, u.pn); u.A = ws + WS_MEMB + (size_t)u.pm * 256 * 2048; u.B = wl + WO_MKV + (size_t)u.pn * 256 * 2048; u.lda2 = 2048; u.ldb2 = 2048; u.nt = 16; u.kind = K_MKV; u.aux = 0; return true;
    } else if (PH == PH_GATE) {
        int j;
        if (C.G > 64) { constexpr int NSC = 5;
            if (C.c < 64) { if (i >= NSC) return false; j = C.c + i * 64; }
            else { j = 64 * NSC + (C.c - 64) + i * (C.G - 64); } }
        else j = C.c + i * C.G;
        if (j >= NRT * 8 + 8) return false;
        int b;
        if (j < NRT * 8) { int pn8; tile_map(j, NRT, 8, u.pm, pn8); b = pn8 >> 2; u.pn = pn8 & 3; }
        else { const int t = j - NRT * 8; u.pm = 256 + (t >> 2); u.pn = t & 3; b = 2; }
        u.aux = b;
        u.A = ws + WS_XB + (size_t)u.pm * 256 * 2048; u.lda2 = 2048; u.B = wl + WO_G + (size_t)(b * 1024 + u.pn * 256) * 2048; u.ldb2 = 2048; u.nt = 16; u.kind = K_GATE2; return true;
    } else if (PH == PH_MERGE) {
        const int Lt = (i >> 2) * C.G + C.c, sub = i & 3; if (Lt >= 256 * 4) return false;
        tile_map(Lt, 256, 4, u.pm, u.pn);
        if (sub == 0) { u.aux = 2; u.A = ws + WS_XB + (size_t)u.pm * 256 * 2048; u.lda2 = 2048; u.B = wl + WO_G + (size_t)(2 * 1024 + u.pn * 256) * 2048; u.ldb2 = 2048; u.nt = 16; u.kind = K_GATE; }
        else { const int b = sub == 1 ? 2 : (sub == 2 ? 0 : 1); u.aux = b | ((sub - 1) << 4);
            const int colbr = b == 0 ? C_GV : (b == 1 ? C_GQ : C_GK);
            u.A = ws + WS_H + (size_t)u.pm * 256 * (HLD * 2) + colbr * 2; u.lda2 = HLD * 2; u.B = wl + WO_BR + (size_t)b * (1024 * 512 * 2) + (size_t)u.pn * 256 * 1024; u.ldb2 = 1024; u.nt = 8; u.kind = K_BR; }
        return true;
    } else if (PH == PH_MERGES) {
        const int sidx = C.c + i * C.G; if (sidx >= 24) return false; const int t = sidx / 3, b = sidx - 3 * t; u.pm = 256 + (t >> 2); u.pn = t & 3; u.aux = b;
        const int colbr = b == 0 ? C_GV : (b == 1 ? C_GQ : C_GK);
        u.A = ws + WS_H + (size_t)u.pm * 256 * (HLD * 2) + colbr * 2; u.lda2 = HLD * 2; u.B = wl + WO_BR + (size_t)b * (1024 * 512 * 2) + (size_t)u.pn * 256 * 1024; u.ldb2 = 1024; u.nt = 8; u.kind = K_BRP; return true;
    } else if (PH == PH_WO) {
        if (i >= 4) return false; u.pm = C.panel; u.pn = i;
        u.A = ws + WS_MERGED + (size_t)u.pm * 256 * 2048; u.B = wl + WO_O + (size_t)u.pn * 256 * 2048; u.lda2 = 2048; u.ldb2 = 2048; u.nt = 16; u.kind = K_RES; u.aux = 1; return true;
    } else if (PH == PH_WOS) {
        const int sidx = C.c + i * C.G; if (sidx >= 32) return false; const int t = sidx >> 2, ks = sidx & 3; u.pm = 256 + (t >> 2); u.pn = t & 3;
        u.A = ws + WS_MERGED + (size_t)u.pm * 256 * 2048 + ks * 512; u.B = wl + WO_O + (size_t)u.pn * 256 * 2048 + ks * 512; u.lda2 = 2048; u.ldb2 = 2048; u.nt = 4; u.kind = K_PART; u.aux = ks; return true;
    } else if (PH == PH_DNS) {
        const int sidx = C.c + i * C.G; if (sidx >= 128) return false; const int t = sidx >> 4, ks = sidx & 15; u.pm = 256 + (t >> 2); u.pn = t & 3;
        u.A = ws + WS_HID + (size_t)u.pm * 256 * 8192 + ks * 512; u.B = wl + WO_DN + (size_t)u.pn * 256 * 8192 + ks * 512; u.lda2 = 8192; u.ldb2 = 8192; u.nt = 4; u.kind = K_PART; u.aux = ks; return true;
    } else if (PH == PH_UP) {
        const int L = i * C.G + C.c; if (L >= NRT * 16) return false; tile_map(L, NRT, 16, u.pm, u.pn);
        u.A = ws + WS_XB + (size_t)u.pm * 256 * 2048; u.B = wl + WO_UP + (size_t)u.pn * 256 * 2048; u.lda2 = 2048; u.ldb2 = 2048; u.nt = 16; u.kind = K_UP; u.aux = 0; return true;
    } else {
        const int L = i * C.G + C.c; if (L >= 256 * 4) return false; tile_map(L, 256, 4, u.pm, u.pn);
        u.A = ws + WS_HID + (size_t)u.pm * 256 * 8192; u.B = wl + WO_DN + (size_t)u.pn * 256 * 8192; u.lda2 = 8192; u.ldb2 = 8192; u.nt = 64; u.kind = K_RES; u.aux = 0; return true;
    }
}

DI void gemm_epilogue(const Ctx& C, int layer, const f32x4 (&acc)[2][2][4][2], const UD& u, int wr, int wc, int fr, int fq, int tid, LAS unsigned char* lds) {
    unsigned char* ws = C.ws;
    const int row0 = u.pm * BM + wr * 64 + fr, col0 = u.pn * BM + wc * 32 + 8 * fq;
    if (u.kind == K_H) {
        bf16_t* H = (bf16_t*)(ws + WS_H);
#pragma unroll
        for (int ai = 0; ai < 2; ++ai)
#pragma unroll
            for (int m = 0; m < 4; ++m) { bf16_t* rowp = H + (size_t)(row0 + ai * HALF + m * 16) * HLD + col0;
#pragma unroll
                for (int bj = 0; bj < 2; ++bj) { const f32x4 v0 = acc[ai][bj][m][0], v1 = acc[ai][bj][m][1];
                    u32x4 w; w.x = pk(v0[0], v0[1]); w.y = pk(v0[2], v0[3]); w.z = pk(v1[0], v1[1]); w.w = pk(v1[2], v1[3]);
                    *(u32x4*)(rowp + bj * HALF) = w; } }
    } else if (u.kind == K_MKV) {
        bf16_t* MK = (bf16_t*)(ws + WS_MKV + (size_t)layer * MKV_L);
#pragma unroll
        for (int ai = 0; ai < 2; ++ai)
#pragma unroll
            for (int m = 0; m < 4; ++m) { const int r = row0 + ai * HALF + m * 16;
#pragma unroll
                for (int bj = 0; bj < 2; ++bj) { const f32x4 v0 = acc[ai][bj][m][0], v1 = acc[ai][bj][m][1]; const int c = col0 + bj * HALF;
                    u32x4 w; w.x = pk(v0[0], v0[1]); w.y = pk(v0[2], v0[3]); w.z = pk(v1[0], v1[1]); w.w = pk(v1[2], v1[3]);
                    *(u32x4*)(MK + (size_t)r * 1024 + c) = w;
                    float* o = C.out + (c < 512 ? O_PMK : O_PMV) + ((size_t)layer * 4096 + r) * 512 + (c & 511);
                    *(f32x4*)o = v0; *(f32x4*)(o + 4) = v1; } }
    } else if (u.kind == K_GATE) {
        unsigned char* gs = ws + WS_GS + (size_t)C.c * 131072;
#pragma unroll
        for (int ai = 0; ai < 2; ++ai)
#pragma unroll
            for (int m = 0; m < 4; ++m)
#pragma unroll
                for (int bj = 0; bj < 2; ++bj) { const f32x4 v0 = acc[ai][bj][m][0], v1 = acc[ai][bj][m][1]; const int idx = (ai * 4 + m) * 2 + bj;
                    u32x4 w; w.x = pk(sigmoidf_(v0[0]), sigmoidf_(v0[1])); w.y = pk(sigmoidf_(v0[2]), sigmoidf_(v0[3])); w.z = pk(sigmoidf_(v1[0]), sigmoidf_(v1[1])); w.w = pk(sigmoidf_(v1[2]), sigmoidf_(v1[3]));
                    unsigned off = (unsigned)(idx * NTHR + tid) * 16u; asm volatile("" : "+v"(off) :: "memory");
                    *(u32x4*)(gs + off) = w; }
    } else if (u.kind == K_BR) {
        unsigned char* gs = ws + WS_GS + (size_t)C.c * 131072;
        bf16_t* MG = (bf16_t*)(ws + WS_MERGED); const int b = u.aux & 15, mode = u.aux >> 4;
        const bf16_t* GT = (const bf16_t*)C.out + (size_t)b * MT * 1024;
#pragma unroll
        for (int ai = 0; ai < 2; ++ai) {
            unsigned off[8]; u32x4 g[8], p[8];
#pragma unroll
            for (int q = 0; q < 8; ++q) { const int m = q >> 1, bj = q & 1; const int idx = (ai * 4 + m) * 2 + bj; off[q] = (unsigned)(idx * NTHR + tid) * 16u; }
            asm volatile("" : "+v"(off[0]), "+v"(off[1]), "+v"(off[2]), "+v"(off[3]), "+v"(off[4]), "+v"(off[5]), "+v"(off[6]), "+v"(off[7]) :: "memory");
#pragma unroll
            for (int q = 0; q < 8; ++q) { const int m = q >> 1, bj = q & 1; const size_t ro = (size_t)(row0 + ai * HALF + m * 16) * 1024 + col0 + bj * HALF;
                if (b == 2) g[q] = *(const u32x4*)(gs + off[q]); else g[q] = *(const u32x4*)(GT + ro);
                if (mode > 0) p[q] = *(const u32x4*)(MG + ro); }
#pragma unroll
            for (int q = 0; q < 8; ++q) { const int m = q >> 1, bj = q & 1; const size_t ro = (size_t)(row0 + ai * HALF + m * 16) * 1024 + col0 + bj * HALF;
                f32x4 v0 = acc[ai][bj][m][0], v1 = acc[ai][bj][m][1];
                v0[0] *= bflo(g[q].x); v0[1] *= bfhi(g[q].x); v0[2] *= bflo(g[q].y); v0[3] *= bfhi(g[q].y); v1[0] *= bflo(g[q].z); v1[1] *= bfhi(g[q].z); v1[2] *= bflo(g[q].w); v1[3] *= bfhi(g[q].w);
                if (mode > 0) { v0[0] += bflo(p[q].x); v0[1] += bfhi(p[q].x); v0[2] += bflo(p[q].y); v0[3] += bfhi(p[q].y); v1[0] += bflo(p[q].z); v1[1] += bfhi(p[q].z); v1[2] += bflo(p[q].w); v1[3] += bfhi(p[q].w); }
                u32x4 w; w.x = pk(v0[0], v0[1]); w.y = pk(v0[2], v0[3]); w.z = pk(v1[0], v1[1]); w.w = pk(v1[2], v1[3]);
                *(u32x4*)(MG + ro) = w; }
            asm volatile("" ::: "memory");
        }
    } else if (u.kind == K_BRP) {
        const int b = u.aux;
        const bf16_t* GT = b < 2 ? (const bf16_t*)C.out + (size_t)b * MT * 1024 : (const bf16_t*)(ws + WS_GT2S) - (size_t)NP * 1024;
        float* SPM = (float*)(ws + WS_SPM) + (size_t)b * 512 * 1024 - (size_t)NP * 1024;
#pragma unroll
        for (int ai = 0; ai < 2; ++ai)
#pragma unroll
            for (int bj = 0; bj < 2; ++bj) {
                u32x4 g[4];
#pragma unroll
                for (int m = 0; m < 4; ++m) g[m] = *(const u32x4*)(GT + (size_t)(row0 + ai * HALF + m * 16) * 1024 + col0 + bj * HALF);
#pragma unroll
                for (int m = 0; m < 4; ++m) { f32x4 v0 = acc[ai][bj][m][0], v1 = acc[ai][bj][m][1];
                    v0[0] *= bflo(g[m].x); v0[1] *= bfhi(g[m].x); v0[2] *= bflo(g[m].y); v0[3] *= bfhi(g[m].y); v1[0] *= bflo(g[m].z); v1[1] *= bfhi(g[m].z); v1[2] *= bflo(g[m].w); v1[3] *= bfhi(g[m].w);
                    float* o = SPM + (size_t)(row0 + ai * HALF + m * 16) * 1024 + col0 + bj * HALF;
                    *(f32x4*)o = v0; *(f32x4*)(o + 4) = v1; }
                asm volatile("" ::: "memory");
            }
    } else if (u.kind == K_GATE2) {
        bf16_t* GT = u.aux < 2 ? (bf16_t*)C.out + (size_t)u.aux * MT * 1024 : (bf16_t*)(ws + WS_GT2S) - (size_t)NP * 1024;
#pragma unroll
        for (int ai = 0; ai < 2; ++ai)
#pragma unroll
            for (int m = 0; m < 4; ++m) { bf16_t* rowp = GT + (size_t)(row0 + ai * HALF + m * 16) * 1024 + col0;
#pragma unroll
                for (int bj = 0; bj < 2; ++bj) { const f32x4 v0 = acc[ai][bj][m][0], v1 = acc[ai][bj][m][1];
                    u32x4 w; w.x = pk(sigmoidf_(v0[0]), sigmoidf_(v0[1])); w.y = pk(sigmoidf_(v0[2]), sigmoidf_(v0[3])); w.z = pk(sigmoidf_(v1[0]), sigmoidf_(v1[1])); w.w = pk(sigmoidf_(v1[2]), sigmoidf_(v1[3]));
                    *(u32x4*)(rowp + bj * HALF) = w; } }
    } else if (u.kind == K_RES) {
        const bf16_t* XB = (const bf16_t*)(ws + WS_XB); float* Y = C.out + O_Y;
        LAS float* stats = (LAS float*)(lds + LDS_STATS);
#pragma unroll
        for (int ai = 0; ai < 2; ++ai) {
            u32x4 xr[4][2];
#pragma unroll
            for (int m = 0; m < 4; ++m)
#pragma unroll
                for (int bj = 0; bj < 2; ++bj) xr[m][bj] = *(const u32x4*)(XB + (size_t)(row0 + ai * HALF + m * 16) * 1024 + col0 + bj * HALF);
#pragma unroll
            for (int m = 0; m < 4; ++m) { const size_t off = (size_t)(row0 + ai * HALF + m * 16) * 1024 + col0;
                float s1 = 0.f, s2 = 0.f;
#pragma unroll
                for (int bj = 0; bj < 2; ++bj) { f32x4 v0 = acc[ai][bj][m][0], v1 = acc[ai][bj][m][1];
                    const u32x4 x = xr[m][bj];
                    v0[0] += DN_ALPHA * bflo(x.x); v0[1] += DN_ALPHA * bfhi(x.x); v0[2] += DN_ALPHA * bflo(x.y); v0[3] += DN_ALPHA * bfhi(x.y);
                    v1[0] += DN_ALPHA * bflo(x.z); v1[1] += DN_ALPHA * bfhi(x.z); v1[2] += DN_ALPHA * bflo(x.w); v1[3] += DN_ALPHA * bfhi(x.w);
                    s1 += (v0[0] + v0[1]) + (v0[2] + v0[3]) + (v1[0] + v1[1]) + (v1[2] + v1[3]);
                    s2 += (v0[0] * v0[0] + v0[1] * v0[1]) + (v0[2] * v0[2] + v0[3] * v0[3]) + (v1[0] * v1[0] + v1[1] * v1[1]) + (v1[2] * v1[2] + v1[3] * v1[3]);
                    if (u.aux) { *(f32x4*)(Y + off + bj * HALF) = v0; *(f32x4*)(Y + off + bj * HALF + 4) = v1; }
                    else { u32x4 w; w.x = pk(v0[0], v0[1]); w.y = pk(v0[2], v0[3]); w.z = pk(v1[0], v1[1]); w.w = pk(v1[2], v1[3]);
                        *(u32x4*)((bf16_t*)(Y + (size_t)(row0 + ai * HALF + m * 16) * 1024) + col0 + bj * HALF) = w; } }
                s1 += __shfl_xor(s1, 16); s1 += __shfl_xor(s1, 32); s2 += __shfl_xor(s2, 16); s2 += __shfl_xor(s2, 32);
                if (fq == 0 && u.aux) { const int rl = ai * HALF + wr * 64 + m * 16 + fr;
                    __hip_atomic_fetch_add(stats + 2 * rl, s1, __ATOMIC_RELAXED, __HIP_MEMORY_SCOPE_WORKGROUP);
                    __hip_atomic_fetch_add(stats + 2 * rl + 1, s2, __ATOMIC_RELAXED, __HIP_MEMORY_SCOPE_WORKGROUP); } }
            asm volatile("" ::: "memory");
        }
    } else if (u.kind == K_PART) {
        float* SP = (float*)(ws + WS_SP) + (size_t)u.aux * 512 * 1024;
#pragma unroll
        for (int ai = 0; ai < 2; ++ai)
#pragma unroll
            for (int m = 0; m < 4; ++m) { const size_t off = (size_t)(row0 + ai * HALF + m * 16 - NP) * 1024 + col0;
#pragma unroll
                for (int bj = 0; bj < 2; ++bj) { *(f32x4*)(SP + off + bj * HALF) = acc[ai][bj][m][0]; *(f32x4*)(SP + off + bj * HALF + 4) = acc[ai][bj][m][1]; } }
    } else {
        bf16_t* HID = (bf16_t*)(ws + WS_HID);
#pragma unroll
        for (int ai = 0; ai < 2; ++ai)
#pragma unroll
            for (int m = 0; m < 4; ++m) { bf16_t* rowp = HID + (size_t)(row0 + ai * HALF + m * 16) * DFF + col0;
#pragma unroll
                for (int bj = 0; bj < 2; ++bj) { f32x4 v0 = acc[ai][bj][m][0], v1 = acc[ai][bj][m][1];
#pragma unroll
                    for (int j = 0; j < 4; ++j) { const float a = fmaxf(v0[j], 0.f), b = fmaxf(v1[j], 0.f); v0[j] = a * a; v1[j] = b * b; }
                    u32x4 w; w.x = pk(v0[0], v0[1]); w.y = pk(v0[2], v0[3]); w.z = pk(v1[0], v1[1]); w.w = pk(v1[2], v1[3]);
                    *(u32x4*)(rowp + bj * HALF) = w; } }
    }
}

template <int PH>
DI void gemm_phase(LAS unsigned char* lds, const Ctx& C, int layer) {
    int tid_ = threadIdx.x; asm volatile("" : "+v"(tid_));
    const int tid = tid_, wid = __builtin_amdgcn_readfirstlane(tid >> 6), lane = tid & 63, wr = wid >> 2, wc = wid & 3, fr = lane & 15, fq = lane >> 4;
    int R0, C0; stage_rc(tid * 16, R0, C0);
    const int Rb0 = (R0 & ~31) + perm32(R0 & 31);
    const size_t kstep = (size_t)(BK * 2);
    const unsigned ldsw = (unsigned)wid * 1024u;
    const int aoff = lds_byte(wr * 64 + fr, fq * 8), boff = lds_byte(wc * 32 + fr, fq * 8);
#define G_SA(b, h) (((b) * 2 + (h)) * HTB)
#define G_SB(b, h) ((4 + (b) * 2 + (h)) * HTB)
#define G_STAGE(bufoff, gbase, v0, h64) do { \
        __builtin_amdgcn_global_load_lds((const unsigned*)((const char*)(gbase) + (v0)), (LAS unsigned*)(lds + (bufoff) + ldsw), 16, 0, 0); \
        __builtin_amdgcn_global_load_lds((const unsigned*)((const char*)(gbase) + (h64) + (v0)), (LAS unsigned*)(lds + (bufoff) + ldsw + 8192), 16, 0, 0); } while (0)
#define G_LDA(dst, b, h) do { _Pragma("unroll") for (int m = 0; m < 4; ++m) _Pragma("unroll") for (int k = 0; k < 2; ++k) dst[m][k] = *(const LAS bf16x8*)(lds + G_SA(b, h) + aoff + m * 2048 + k * 1024); } while (0)
#define G_LDB(dst, b, h) do { _Pragma("unroll") for (int n = 0; n < 2; ++n) _Pragma("unroll") for (int k = 0; k < 2; ++k) dst[n][k] = *(const LAS bf16x8*)(lds + G_SB(b, h) + boff + n * 2048 + k * 1024); } while (0)
#define G_MMA(ai, bj, At, Bt) do { __builtin_amdgcn_s_setprio(1); _Pragma("unroll") for (int m = 0; m < 4; ++m) _Pragma("unroll") for (int n = 0; n < 2; ++n) _Pragma("unroll") for (int k = 0; k < 2; ++k) \
        acc[ai][bj][m][n] = __builtin_amdgcn_mfma_f32_16x16x32_bf16(Bt[n][k], At[m][k], acc[ai][bj][m][n], 0, 0, 0); __builtin_amdgcn_s_setprio(0); } while (0)
#define G_WAIT_V(n) asm volatile("s_waitcnt vmcnt(" #n ")" ::: "memory")
#define G_WAIT_L(n) asm volatile("s_waitcnt lgkmcnt(" #n ")" ::: "memory")
#define G_BAR __builtin_amdgcn_s_barrier()
#define G_SCHED __builtin_amdgcn_sched_barrier(0)
    UD cur, nxt; int ui = 0;
    if (!get_unit<PH>(C, layer, 0, cur)) return;
    f32x4 acc[2][2][4][2];
#pragma unroll
    for (int a = 0; a < 2; ++a)
#pragma unroll
        for (int b = 0; b < 2; ++b)
#pragma unroll
            for (int m = 0; m < 4; ++m)
#pragma unroll
                for (int n = 0; n < 2; ++n) acc[a][b][m][n] = (f32x4){0.f, 0.f, 0.f, 0.f};
    bf16x8 At[4][2], B0[2][2], B1[2][2];
    const char* cA = cur.A; const char* cB = cur.B;
    unsigned cvA0 = (unsigned)R0 * cur.lda2 + C0 * 2, cvB0 = (unsigned)Rb0 * cur.ldb2 + C0 * 2;
    size_t chA = (size_t)HALF * cur.lda2, chB = (size_t)HALF * cur.ldb2;
    G_STAGE(G_SB(0, 0), cB, cvB0, chB / 2); G_STAGE(G_SA(0, 0), cA, cvA0, chA / 2); G_STAGE(G_SB(0, 1), cB + chB, cvB0, chB / 2); G_STAGE(G_SA(0, 1), cA + chA, cvA0, chA / 2);
    if (wr == 1) G_BAR;
    G_WAIT_V(4); G_BAR;
    G_STAGE(G_SB(1, 0), cB + kstep, cvB0, chB / 2); G_STAGE(G_SA(1, 0), cA + kstep, cvA0, chA / 2); G_STAGE(G_SB(1, 1), cB + chB + kstep, cvB0, chB / 2);
    G_WAIT_V(6); G_BAR;
    for (;;) {
        const bool has_next = get_unit<PH>(C, layer, ui + 1, nxt);
        if (!has_next) nxt = cur;
        const char* nA = nxt.A; const char* nB = nxt.B;
        const unsigned nvA0 = (unsigned)R0 * nxt.lda2 + C0 * 2, nvB0 = (unsigned)Rb0 * nxt.ldb2 + C0 * 2;
        const size_t nhA = (size_t)HALF * nxt.lda2, nhB = (size_t)HALF * nxt.ldb2;
        const int nt = cur.nt;
        for (int t = 0; t < nt; t += 2) {
            const bool last = (t == nt - 2);
            const char* a1 = cA + (size_t)(t + 1) * kstep;
            const char* a2 = last ? nA : cA + (size_t)(t + 2) * kstep; const char* b2 = last ? nB : cB + (size_t)(t + 2) * kstep;
            const char* a3 = a2 + kstep; const char* b3 = b2 + kstep;
            const unsigned sA0 = last ? nvA0 : cvA0, sB0 = last ? nvB0 : cvB0;
            const size_t shA = last ? nhA : chA, shB = last ? nhB : chB;
            G_LDB(B0, 0, 0); G_SCHED; G_LDA(At, 0, 0); G_STAGE(G_SA(1, 1), a1 + chA, cvA0, chA / 2);
            G_WAIT_L(8); G_BAR; G_WAIT_L(0); G_MMA(0, 0, At, B0); G_BAR; G_SCHED;
            G_LDB(B1, 0, 1); G_STAGE(G_SB(0, 0), b2, sB0, shB / 2);
            G_BAR; G_WAIT_L(0); G_MMA(0, 1, At, B1); G_BAR;
            G_LDA(At, 0, 1); G_STAGE(G_SA(0, 0), a2, sA0, shA / 2);
            G_BAR; G_WAIT_L(0); G_MMA(1, 0, At, B0); G_BAR; G_SCHED;
            G_STAGE(G_SB(0, 1), b2 + shB, sB0, shB / 2);
            G_WAIT_V(6); G_BAR; G_MMA(1, 1, At, B1); G_BAR;
            G_LDB(B0, 1, 0); G_SCHED; G_LDA(At, 1, 0); G_STAGE(G_SA(0, 1), a2 + shA, sA0, shA / 2);
            G_WAIT_L(8); G_BAR; G_WAIT_L(0); G_MMA(0, 0, At, B0); G_BAR; G_SCHED;
            G_LDB(B1, 1, 1); G_STAGE(G_SB(1, 0), b3, sB0, shB / 2);
            G_BAR; G_WAIT_L(0); G_MMA(0, 1, At, B1); G_BAR;
            G_LDA(At, 1, 1); G_STAGE(G_SA(1, 0), a3, sA0, shA / 2);
            G_BAR; G_WAIT_L(0); G_MMA(1, 0, At, B0); G_BAR; G_SCHED;
            G_STAGE(G_SB(1, 1), b3 + shB, sB0, shB / 2);
            G_WAIT_V(6); G_BAR; G_MMA(1, 1, At, B1); G_BAR;
        }
        gemm_epilogue(C, layer, acc, cur, wr, wc, fr, fq, tid, lds);
        if (!has_next) break;
#pragma unroll
        for (int a = 0; a < 2; ++a)
#pragma unroll
            for (int b = 0; b < 2; ++b)
#pragma unroll
                for (int m = 0; m < 4; ++m)
#pragma unroll
                    for (int n = 0; n < 2; ++n) acc[a][b][m][n] = (f32x4){0.f, 0.f, 0.f, 0.f};
        cur = nxt; cA = nA; cB = nB; cvA0 = nvA0; cvB0 = nvB0; chA = nhA; chB = nhB; ++ui;
    }
    G_WAIT_V(0);
    if (wr == 0) G_BAR;
    G_BAR;
#undef G_SA
#undef G_SB
#undef G_STAGE
#undef G_LDA
#undef G_LDB
#undef G_MMA
#undef G_WAIT_V
#undef G_WAIT_L
#undef G_BAR
#undef G_SCHED
}

DI void transpose_item(const float* W, int ldw, int srccol, int nvalid, bf16_t* WT, int K, int dstrow, int k0, LAS float* scr, int lane) {
    const int n = lane & 31;
#pragma unroll 16
    for (int i = 0; i < 32; ++i) { const int kk = 2 * i + (lane >> 5); scr[kk * 33 + n] = (n < nvalid) ? W[(size_t)(k0 + kk) * ldw + srccol + n] : 0.f; }
    asm volatile("s_waitcnt lgkmcnt(0)" ::: "memory");
    const int c = lane & 7;
#pragma unroll
    for (int j = 0; j < 4; ++j) { const int nn = (lane >> 3) + 8 * j; const LAS float* s = scr + (8 * c) * 33 + nn;
        u32x4 o; o.x = pk(s[0 * 33], s[1 * 33]); o.y = pk(s[2 * 33], s[3 * 33]); o.z = pk(s[4 * 33], s[5 * 33]); o.w = pk(s[6 * 33], s[7 * 33]);
        *(u32x4*)(WT + (size_t)(dstrow + nn) * K + k0 + 8 * c) = o; }
    asm volatile("s_waitcnt lgkmcnt(0)" ::: "memory");
}

DI void cvt8(const float* src, bf16_t* dst) {
    const f32x4 a = *(const f32x4*)src, b = *(const f32x4*)(src + 4);
    u32x4 w; w.x = pk(a[0], a[1]); w.y = pk(a[2], a[3]); w.z = pk(b[0], b[1]); w.w = pk(b[2], b[3]);
    *(u32x4*)dst = w;
}

DI void p0_convert(LAS unsigned char* lds, const Ctx& C) {
    int tid_ = threadIdx.x; asm volatile("" : "+v"(tid_));
    const int tid = tid_, lane = tid & 63, wid = tid >> 6;
    LAS float* scr = (LAS float*)(lds + wid * 16384);
    const int gw = C.c * 8 + wid, NGW = C.G * 8;
    constexpr int PER_L = 1792 + 1536 + 768 + 512 + 2048 + 2048 + 512;
    for (int it = gw; it < 2 * PER_L; it += NGW) {
        const int l = it / PER_L; int r = it % PER_L;
        unsigned char* wl = C.ws + WS_W + (size_t)l * WL_BYTES;
        if (r < 1792) { const int nb = r >> 4, kb = r & 15, d0 = nb * 32; int src = 0, nv = 32;
            if (d0 < 1536) src = d0; else if (d0 < 3328) src = d0 + 8; else if (d0 == 3328) { src = 1536; nv = 8; } else nv = 0;
            transpose_item(C.w_in + (size_t)l * DM * DIN, DIN, src, nv, (bf16_t*)(wl + WO_IN), 1024, d0, kb * 64, scr, lane); continue; }
        r -= 1792;
        if (r < 1536) { const int nb = r >> 4, kb = r & 15;
            transpose_item(C.w_in + (size_t)l * DM * DIN, DIN, 3336 + nb * 32, 32, (bf16_t*)(wl + WO_G), 1024, nb * 32, kb * 64, scr, lane); continue; }
        r -= 1536;
        if (r < 768) { const int b = r >> 8, rr = r & 255, nb = rr >> 3, kb = rr & 7;
            transpose_item(C.w_br + (size_t)(l * 3 + b) * 512 * 1024, 1024, nb * 32, 32, (bf16_t*)(wl + WO_BR) + (size_t)b * 1024 * 512, 512, nb * 32, kb * 64, scr, lane); continue; }
        r -= 768;
        if (r < 512) { const int nb = r >> 4, kb = r & 15;
            transpose_item(C.w_o + (size_t)l * 1024 * 1024, 1024, nb * 32, 32, (bf16_t*)(wl + WO_O), 1024, nb * 32, kb * 64, scr, lane); continue; }
        r -= 512;
        if (r < 2048) { const int nb = r >> 4, kb = r & 15;
            transpose_item(C.w_up + (size_t)l * 1024 * 4096, 4096, nb * 32, 32, (bf16_t*)(wl + WO_UP), 1024, nb * 32, kb * 64, scr, lane); continue; }
        r -= 2048;
        if (r < 2048) { const int nb = r >> 6, kb = r & 63;
            transpose_item(C.w_dn + (size_t)l * 4096 * 1024, 1024, nb * 32, 32, (bf16_t*)(wl + WO_DN), 4096, nb * 32, kb * 64, scr, lane); continue; }
        r -= 2048;
        { const int nb = r >> 4, kb = r & 15;
            transpose_item(C.w_mkv + (size_t)l * 1024 * 1024, 1024, nb * 32, 32, (bf16_t*)(wl + WO_MKV), 1024, nb * 32, kb * 64, scr, lane); }
    }
    const size_t gt = (size_t)C.c * NTHR + tid, GT = (size_t)C.G * NTHR;
    bf16_t* XB = (bf16_t*)(C.ws + WS_XB);
    {
        const size_t NG = (size_t)MT * 128;
        for (size_t i = gt; i < NG; i += 4 * GT) {
            f32x4 a[4], b[4]; size_t e[4]; bool ok[4];
#pragma unroll
            for (int k = 0; k < 4; ++k) { const size_t ii = i + (size_t)k * GT; ok[k] = ii < NG; e[k] = (ok[k] ? ii : i) * 8;
                const float* sp = e[k] < (size_t)NP * 1024 ? C.xp + e[k] : C.xs + (e[k] - (size_t)NP * 1024);
                a[k] = *(const f32x4*)sp; b[k] = *(const f32x4*)(sp + 4); }
#pragma unroll
            for (int k = 0; k < 4; ++k) if (ok[k]) { u32x4 w; w.x = pk(a[k][0], a[k][1]); w.y = pk(a[k][2], a[k][3]); w.z = pk(b[k][0], b[k][1]); w.w = pk(b[k][2], b[k][3]); *(u32x4*)(XB + e[k]) = w; }
        }
    }
    bf16_t* MB = (bf16_t*)(C.ws + WS_MEMB);
    for (size_t i = gt; i < (size_t)4096 * 128; i += GT) cvt8(C.memp + i * 8, MB + i * 8);
    for (size_t i = gt; i < (size_t)2 * 8192 * 128; i += GT) { const int c8 = (int)(i & 127); const size_t rr = (i >> 7) & 8191, l = i >> 20; const int c = c8 * 8;
        const float* s = (c < 512 ? C.cmk : C.cmv) + ((l * 8192 + rr) * 512 + (c & 511));
        cvt8(s, (bf16_t*)(C.ws + WS_MKV + l * MKV_L) + (4096 + rr) * 1024 + c); }
    for (size_t i = gt; i < (size_t)2 * 4096 * 32; i += GT) { const int c8 = (int)(i & 31); const size_t rr = (i >> 5) & 4095, l = i >> 17; const int c = c8 * 8;
        const float* s = (c < 128 ? C.csk : C.csv) + ((l * 4096 + rr) * 128 + (c & 127));
        cvt8(s, (bf16_t*)(C.ws + WS_SWC + l * SWC_L) + rr * 256 + c); }
}

DI void ln_zero_stats(LAS unsigned char* lds) {
    int tid_ = threadIdx.x; asm volatile("" : "+v"(tid_));
    ((LAS float*)(lds + LDS_STATS))[tid_] = 0.f;
    __syncthreads();
}
DI void ln_panel_sweep(LAS unsigned char* lds, const Ctx& C, int panel, const float* gam, const float* bet, bool final_out) {
    int tid_ = threadIdx.x; asm volatile("" : "+v"(tid_));
    const int tid = tid_, lane = tid & 63, wid = tid >> 6;
    __syncthreads();
    const LAS float* stats = (const LAS float*)(lds + LDS_STATS);
    float* Y = C.out + O_Y; bf16_t* XB = (bf16_t*)(C.ws + WS_XB);
    f32x4 g4[4], b4[4];
#pragma unroll
    for (int j = 0; j < 4; ++j) { g4[j] = ((const f32x4*)gam)[lane + 64 * j]; b4[j] = ((const f32x4*)bet)[lane + 64 * j]; }
#pragma unroll 2
    for (int rr = wid; rr < 256; rr += 8) {
        const int row = panel * 256 + rr;
        const float mean = stats[2 * rr] * (1.f / 1024.f);
        const float var = fmaxf(stats[2 * rr + 1] * (1.f / 1024.f) - mean * mean, 0.f);
        const float rstd = rsqrtf(var + 1e-5f);
        f32x4* yr = (f32x4*)(Y + (size_t)row * 1024) + lane;
#pragma unroll
        for (int j = 0; j < 4; ++j) { const f32x4 o4 = (yr[64 * j] - mean) * rstd * g4[j] + b4[j];
            if (final_out) yr[64 * j] = o4;
            else { u32x2 w; w.x = pk(o4[0], o4[1]); w.y = pk(o4[2], o4[3]); *((u32x2*)(XB + (size_t)row * 1024) + lane + 64 * j) = w; } }
    }
    __syncthreads();
}
DI void ln_sample(const Ctx& C, int nsplit, const float* gam, const float* bet, bool final_out) {
    int tid_ = threadIdx.x; asm volatile("" : "+v"(tid_));
    const int tid = tid_, lane = tid & 63, wid = tid >> 6;
    float* Y = C.out + O_Y; bf16_t* XB = (bf16_t*)(C.ws + WS_XB); const float* SP = (const float*)(C.ws + WS_SP);
    for (int r = C.c * 8 + wid; r < NS; r += C.G * 8) {
        const int row = NP + r;
        f32x4 v[4]; float s = 0.f;
#pragma unroll
        for (int j = 0; j < 4; ++j) { const u32x2 x = *((const u32x2*)(XB + (size_t)row * 1024) + lane + 64 * j);
            v[j] = (f32x4){DN_ALPHA * bflo(x.x), DN_ALPHA * bfhi(x.x), DN_ALPHA * bflo(x.y), DN_ALPHA * bfhi(x.y)}; }
        for (int sp = 0; sp < nsplit; ++sp) { const f32x4* pr = (const f32x4*)(SP + ((size_t)sp * 512 + r) * 1024) + lane;
#pragma unroll
            for (int j = 0; j < 4; ++j) v[j] += pr[64 * j]; }
#pragma unroll
        for (int j = 0; j < 4; ++j) s += (v[j][0] + v[j][1]) + (v[j][2] + v[j][3]);
#pragma unroll
        for (int o = 1; o < 64; o <<= 1) s += __shfl_xor(s, o);
        const float mean = s * (1.f / 1024.f); float s2 = 0.f;
#pragma unroll
        for (int j = 0; j < 4; ++j) { v[j] = v[j] - mean; s2 += (v[j][0] * v[j][0] + v[j][1] * v[j][1]) + (v[j][2] * v[j][2] + v[j][3] * v[j][3]); }
#pragma unroll
        for (int o = 1; o < 64; o <<= 1) s2 += __shfl_xor(s2, o);
        const float rstd = rsqrtf(s2 * (1.f / 1024.f) + 1e-5f);
#pragma unroll
        for (int j = 0; j < 4; ++j) { const f32x4 g4 = ((const f32x4*)gam)[lane + 64 * j], b4 = ((const f32x4*)bet)[lane + 64 * j]; const f32x4 o4 = v[j] * rstd * g4 + b4;
            if (final_out) *((f32x4*)(Y + (size_t)row * 1024) + lane + 64 * j) = o4;
            else { u32x2 w; w.x = pk(o4[0], o4[1]); w.y = pk(o4[2], o4[3]); *((u32x2*)(XB + (size_t)row * 1024) + lane + 64 * j) = w; } }
    }
}

DI void ln_phase(const Ctx& C, const float* gam, const float* bet, bool final_out) {
    int tid_ = threadIdx.x; asm volatile("" : "+v"(tid_));
    const int tid = tid_, lane = tid & 63, wid = tid >> 6;
    float* Y = C.out + O_Y; bf16_t* XB = (bf16_t*)(C.ws + WS_XB);
    f32x4 g4[4], b4[4];
#pragma unroll
    for (int j = 0; j < 4; ++j) { g4[j] = ((const f32x4*)gam)[lane + 64 * j]; b4[j] = ((const f32x4*)bet)[lane + 64 * j]; }
    for (int row0 = (C.c * 8 + wid) * 2; row0 < NP; row0 += C.G * 16) {
        u32x2 raw[2][4];
#pragma unroll
        for (int rr = 0; rr < 2; ++rr)
#pragma unroll
            for (int j = 0; j < 4; ++j) raw[rr][j] = *((const u32x2*)(Y + (size_t)(row0 + rr) * 1024) + lane + 64 * j);
#pragma unroll
        for (int rr = 0; rr < 2; ++rr) {
            const int row = row0 + rr;
            f32x4 v[4]; float s = 0.f;
#pragma unroll
            for (int j = 0; j < 4; ++j) { v[j] = (f32x4){bflo(raw[rr][j].x), bfhi(raw[rr][j].x), bflo(raw[rr][j].y), bfhi(raw[rr][j].y)}; s += (v[j][0] + v[j][1]) + (v[j][2] + v[j][3]); }
#pragma unroll
            for (int o = 1; o < 64; o <<= 1) s += __shfl_xor(s, o);
            const float mean = s * (1.f / 1024.f); float s2 = 0.f;
#pragma unroll
            for (int j = 0; j < 4; ++j) { v[j] = v[j] - mean; s2 += (v[j][0] * v[j][0] + v[j][1] * v[j][1]) + (v[j][2] * v[j][2] + v[j][3] * v[j][3]); }
#pragma unroll
            for (int o = 1; o < 64; o <<= 1) s2 += __shfl_xor(s2, o);
            const float rstd = rsqrtf(s2 * (1.f / 1024.f) + 1e-5f);
#pragma unroll
            for (int j = 0; j < 4; ++j) { const f32x4 o4 = v[j] * rstd * g4[j] + b4[j];
                if (final_out) *((f32x4*)(Y + (size_t)row * 1024) + lane + 64 * j) = o4;
                else { u32x2 w; w.x = pk(o4[0], o4[1]); w.y = pk(o4[2], o4[3]); *((u32x2*)(XB + (size_t)row * 1024) + lane + 64 * j) = w; } }
        }
    }
}
DI void merge_fixup(const Ctx& C) {
    int tid_ = threadIdx.x; asm volatile("" : "+v"(tid_));
    const float* SPM = (const float*)(C.ws + WS_SPM); bf16_t* MG = (bf16_t*)(C.ws + WS_MERGED) + (size_t)NP * 1024;
    for (int i = C.c * NTHR + tid_; i < 512 * 128; i += C.G * NTHR) { const size_t e = (size_t)i * 8;
        f32x4 a = *(const f32x4*)(SPM + e), b = *(const f32x4*)(SPM + e + 4);
#pragma unroll
        for (int k = 1; k < 3; ++k) { a += *(const f32x4*)(SPM + (size_t)k * 512 * 1024 + e); b += *(const f32x4*)(SPM + (size_t)k * 512 * 1024 + e + 4); }
        u32x4 w; w.x = pk(a[0], a[1]); w.y = pk(a[2], a[3]); w.z = pk(b[0], b[1]); w.w = pk(b[2], b[3]);
        *(u32x4*)(MG + e) = w; }
}

DI void state_copies(const Ctx& C, int l) {
    const bf16_t* H = (const bf16_t*)(C.ws + WS_H);
    int tid_ = threadIdx.x; asm volatile("" : "+v"(tid_));
    const size_t gt = (size_t)C.c * NTHR + tid_, GT = (size_t)C.G * NTHR;
    for (size_t i = gt; i < (size_t)16 * 3 * 1536; i += GT) { const int c = (int)(i % 1536); const int j = (int)((i / 1536) % 3), b = (int)(i / 4608);
        C.out[O_PGC + (size_t)l * 73728 + i] = bf2f(H[(size_t)(b * 4096 + 4093 + j) * HLD + c]); }
    for (size_t i = gt; i < (size_t)32 * 3 * 1536; i += GT) { const int c = (int)(i % 1536); const int j = (int)((i / 1536) % 3), sb = (int)(i / 4608);
        C.out[O_SGC + (size_t)l * 147456 + i] = bf2f(H[(size_t)(NP + sb * 16 + 13 + j) * HLD + c]); }
    for (size_t i = gt; i < (size_t)16 * 128 * 128; i += GT) { const int c = (int)(i & 127), r = (int)((i >> 7) & 127), b = (int)(i >> 14);
        const bf16_t* hr = H + (size_t)(b * 4096 + 3968 + r) * HLD;
        C.out[O_PSK + (size_t)l * 262144 + i] = bf2f(hr[C_SK + c]); C.out[O_PSV + (size_t)l * 262144 + i] = bf2f(hr[C_SV + c]); }
    for (size_t i = gt; i < (size_t)32 * 128 * 128; i += GT) { const int c = (int)(i & 127), r = (int)((i >> 7) & 127), sb = (int)(i >> 14);
        float k, v;
        if (r < 112) { const size_t si = (((size_t)l * 32 + sb) * 128 + (r + 16)) * 128 + c; k = C.csk[si]; v = C.csv[si]; }
        else { const bf16_t* hr = H + (size_t)(NP + sb * 16 + (r - 112)) * HLD; k = bf2f(hr[C_SK + c]); v = bf2f(hr[C_SV + c]); }
        C.out[O_SSK + (size_t)l * 524288 + i] = k; C.out[O_SSV + (size_t)l * 524288 + i] = v; }
}

DI void conv_load(const bf16_t* H, int rowbase, int pos0, int tok, bool tv, int col, u32x4 (&ha)[4], u32x4 (&hb)[4]) {
#pragma unroll
    for (int w = 0; w < 4; ++w) {
        const int pos = pos0 + tok - 3 + w;
        ha[w] = (u32x4){0u, 0u, 0u, 0u}; hb[w] = (u32x4){0u, 0u, 0u, 0u};
        if (tv && pos >= 0) { const u32x4* p = (const u32x4*)(H + (size_t)(rowbase + pos) * HLD + col); ha[w] = p[0]; hb[w] = p[1]; }
    }
}
DI void conv_compute(const Ctx& C, int l, int pos0, int tok, bool tv, bool sample, int sb, int col, const LAS float* cwl, const u32x4 (&ha)[4], const u32x4 (&hb)[4], float (&o)[16]) {
#pragma unroll
    for (int i = 0; i < 16; ++i) o[i] = 0.f;
#pragma unroll
    for (int w = 0; w < 4; ++w) {
        const int pos = pos0 + tok - 3 + w;
        float xv[16];
        const u32x4 a = ha[w], b = hb[w];
        xv[0] = bflo(a.x); xv[1] = bfhi(a.x); xv[2] = bflo(a.y); xv[3] = bfhi(a.y); xv[4] = bflo(a.z); xv[5] = bfhi(a.z); xv[6] = bflo(a.w); xv[7] = bfhi(a.w);
        xv[8] = bflo(b.x); xv[9] = bfhi(b.x); xv[10] = bflo(b.y); xv[11] = bfhi(b.y); xv[12] = bflo(b.z); xv[13] = bfhi(b.z); xv[14] = bflo(b.w); xv[15] = bfhi(b.w);
        if (tv && sample && pos < 0) {
            const f32x4* p = (const f32x4*)(C.st_conv + (((size_t)l * 32 + sb) * 3 + (3 + pos)) * 1536 + col);
#pragma unroll
            for (int q = 0; q < 4; ++q) { const f32x4 t = p[q]; xv[4 * q] = t[0]; xv[4 * q + 1] = t[1]; xv[4 * q + 2] = t[2]; xv[4 * q + 3] = t[3]; }
        }
#pragma unroll
        for (int q = 0; q < 4; ++q) { const f32x4 t = *(const LAS f32x4*)(cwl + w * 128 + 4 * q); o[4 * q] += xv[4 * q] * t[0]; o[4 * q + 1] += xv[4 * q + 1] * t[1]; o[4 * q + 2] += xv[4 * q + 2] * t[2]; o[4 * q + 3] += xv[4 * q + 3] * t[3]; }
    }
#pragma unroll
    for (int i = 0; i < 16; ++i) o[i] = tv ? o[i] * sigmoidf_(o[i]) : 0.f;
}

constexpr int PP_HB = 53248;
DI void gdn_pre_pair(LAS unsigned char* lds, const Ctx& C, int l, int pair) {
    int tid_ = threadIdx.x; asm volatile("" : "+v"(tid_));
    const int tid = tid_, lane = tid & 63, wid = tid >> 6, half = tid >> 8, ltid = tid & 255, lw = wid & 3;
    const int h = pair & 3, ci = (pair >> 2) * 2 + half, item = ci * 4 + h;
    int rowbase, pos0, nvalid, sb = 0; bool sample;
    if (ci < 1024) { rowbase = (ci >> 6) * 4096; pos0 = (ci & 63) * 64; nvalid = 64; sample = false; }
    else { sb = ci - 1024; rowbase = NP + sb * 16; pos0 = 0; nvalid = 16; sample = true; }
    const bf16_t* H = (const bf16_t*)(C.ws + WS_H);
    LAS unsigned char* hb = lds + half * PP_HB;
    LAS bf16_t* kB = (LAS bf16_t*)(hb); LAS bf16_t* qB = (LAS bf16_t*)(hb + 17408); LAS float* Lm = (LAS float*)(hb + 17408);
    LAS bf16_t* RU = (LAS bf16_t*)(hb + 34816); LAS float* gs = (LAS float*)(hb + 52224);
    LAS float* cwL = (LAS float*)(lds + 2 * PP_HB);
    unsigned char* gp = C.ws + WS_G + (size_t)item * GP_ITEM;
    bf16_t* oNW = (bf16_t*)gp; bf16_t* oQE = (bf16_t*)(gp + 16384); bf16_t* oKDT = (bf16_t*)(gp + 32768); bf16_t* oUT = (bf16_t*)(gp + 49152); bf16_t* oQK = (bf16_t*)(gp + 65536);
    const int tok = ltid >> 2, grp = ltid & 3, c0 = grp * 32;
    const bool tv = tok < nvalid;
    u32x4 hA[3][2][4], hB[3][2][4];
    conv_load(H, rowbase, pos0, tok, tv, 0 * 512 + h * 128 + c0, hA[0][0], hB[0][0]); conv_load(H, rowbase, pos0, tok, tv, 0 * 512 + h * 128 + c0 + 16, hA[0][1], hB[0][1]);
    if (ltid < 64) {
        float g = 0.f, be = 0.f;
        if (ltid < nvalid) {
            const bf16_t* hr = H + (size_t)(rowbase + pos0 + ltid) * HLD;
            const float a = bf2f(hr[C_A + h]), bb = bf2f(hr[C_B + h]);
            const float x = a + C.dt_bias[l * 4 + h];
            const float sp = fmaxf(x, 0.f) + __logf(1.f + __expf(-fabsf(x)));
            g = -__expf(C.a_log[l * 4 + h]) * sp;
            be = sigmoidf_(bb);
        }
        float c = g;
#pragma unroll
        for (int o = 1; o < 64; o <<= 1) { const float t = __shfl_up(c, o); if (lane >= o) c += t; }
        gs[ltid] = be * __expf(c); gs[64 + ltid] = be; gs[128 + ltid] = c; gs[192 + ltid] = 1.f;
    } else {
        const int idx = half * 192 + (ltid - 64), seg = idx >> 7, ch = idx & 127;
#pragma unroll
        for (int w = 0; w < 4; ++w) cwL[(seg * 4 + w) * 128 + ch] = C.conv_w[((size_t)l * 4 + w) * 1536 + seg * 512 + h * 128 + ch];
    }
    __syncthreads();
    const float gc = gs[128 + tok], glast = gs[128 + 63];
    const float beta = gs[64 + tok], egc = __expf(gc);
#pragma unroll
    for (int seg = 0; seg < 3; ++seg) {
        float va[16], vb[16];
        if (seg < 2) { conv_load(H, rowbase, pos0, tok, tv, (seg + 1) * 512 + h * 128 + c0, hA[seg + 1 < 3 ? seg + 1 : 2][0], hB[seg + 1 < 3 ? seg + 1 : 2][0]);
                       conv_load(H, rowbase, pos0, tok, tv, (seg + 1) * 512 + h * 128 + c0 + 16, hA[seg + 1 < 3 ? seg + 1 : 2][1], hB[seg + 1 < 3 ? seg + 1 : 2][1]); }
        conv_compute(C, l, pos0, tok, tv, sample, sb, seg * 512 + h * 128 + c0, cwL + seg * 512 + c0, hA[seg][0], hB[seg][0], va);
        conv_compute(C, l, pos0, tok, tv, sample, sb, seg * 512 + h * 128 + c0 + 16, cwL + seg * 512 + c0 + 16, hA[seg][1], hB[seg][1], vb);
        float sc = beta;
        if (seg < 2) {
            float ss = 0.f;
#pragma unroll
            for (int i = 0; i < 16; ++i) ss += va[i] * va[i] + vb[i] * vb[i];
            ss += __shfl_xor(ss, 1); ss += __shfl_xor(ss, 2);
            sc = rsqrtf(ss + 1e-6f) * (seg == 0 ? 0.08838834764831845f : 1.f);
        }
#pragma unroll
        for (int i = 0; i < 16; ++i) { va[i] *= sc; vb[i] *= sc; }
        LAS bf16_t* dst = (seg == 0 ? qB : (seg == 1 ? kB : RU)) + tok * 136 + c0;
        u32x4 w0, w1, w2, w3;
        w0.x = pk(va[0], va[1]); w0.y = pk(va[2], va[3]); w0.z = pk(va[4], va[5]); w0.w = pk(va[6], va[7]);
        w1.x = pk(va[8], va[9]); w1.y = pk(va[10], va[11]); w1.z = pk(va[12], va[13]); w1.w = pk(va[14], va[15]);
        w2.x = pk(vb[0], vb[1]); w2.y = pk(vb[2], vb[3]); w2.z = pk(vb[4], vb[5]); w2.w = pk(vb[6], vb[7]);
        w3.x = pk(vb[8], vb[9]); w3.y = pk(vb[10], vb[11]); w3.z = pk(vb[12], vb[13]); w3.w = pk(vb[14], vb[15]);
        *(LAS u32x4*)(dst) = w0; *(LAS u32x4*)(dst + 8) = w1; *(LAS u32x4*)(dst + 16) = w2; *(LAS u32x4*)(dst + 24) = w3;
        if (seg == 0) {
            u32x4 e0, e1, e2, e3;
            e0.x = pk(va[0] * egc, va[1] * egc); e0.y = pk(va[2] * egc, va[3] * egc); e0.z = pk(va[4] * egc, va[5] * egc); e0.w = pk(va[6] * egc, va[7] * egc);
            e1.x = pk(va[8] * egc, va[9] * egc); e1.y = pk(va[10] * egc, va[11] * egc); e1.z = pk(va[12] * egc, va[13] * egc); e1.w = pk(va[14] * egc, va[15] * egc);
            e2.x = pk(vb[0] * egc, vb[1] * egc); e2.y = pk(vb[2] * egc, vb[3] * egc); e2.z = pk(vb[4] * egc, vb[5] * egc); e2.w = pk(vb[6] * egc, vb[7] * egc);
            e3.x = pk(vb[8] * egc, vb[9] * egc); e3.y = pk(vb[10] * egc, vb[11] * egc); e3.z = pk(vb[12] * egc, vb[13] * egc); e3.w = pk(vb[14] * egc, vb[15] * egc);
            bf16_t* qe = oQE + tok * 128 + c0;
            *(u32x4*)(qe) = e0; *(u32x4*)(qe + 8) = e1; *(u32x4*)(qe + 16) = e2; *(u32x4*)(qe + 24) = e3;
        }
        asm volatile("" ::: "memory");
    }
    __syncthreads();
    const int fr = lane & 15, fq = lane >> 4;
    f32x4 ga[2][4];
#pragma unroll
    for (int tk = 0; tk < 2; ++tk) {
        const LAS bf16_t* Xm = tk ? qB : kB;
        bf16x8 xf[4];
#pragma unroll
        for (int ks = 0; ks < 4; ++ks) xf[ks] = *(const LAS bf16x8*)(Xm + (16 * lw + fr) * 136 + 32 * ks + 8 * fq);
#pragma unroll
        for (int nt = 0; nt < 4; ++nt) {
            f32x4 a = {0.f, 0.f, 0.f, 0.f};
#pragma unroll
            for (int ks = 0; ks < 4; ++ks) { const bf16x8 yf = *(const LAS bf16x8*)(kB + (16 * nt + fr) * 136 + 32 * ks + 8 * fq); a = mfma16(xf[ks], yf, a); }
            ga[tk][nt] = a;
        }
    }
    __syncthreads();
#pragma unroll
    for (int nt = 0; nt < 4; ++nt) {
        const int jj = 16 * nt + fr; const float gcj = gs[128 + jj];
#pragma unroll
        for (int j = 0; j < 4; ++j) { const int i = 16 * lw + 4 * fq + j; const float gci = gs[128 + i];
            const float dec = __expf(fminf(gci - gcj, 0.f));
            Lm[i * 68 + jj] = (jj < i) ? gs[64 + i] * ga[0][nt][j] * dec : 0.f;
            oQK[i * 64 + jj] = f2bf((jj <= i) ? ga[1][nt][j] * dec : 0.f); }
    }
    __syncthreads();
    if (lw < 2) {
        const int col = 64 * lw + lane;
        f32x2 x[64];
#pragma unroll
        for (int i = 0; i < 64; i += 2) {
            f32x2 a0 = {bf2f(RU[i * 136 + col]), bf2f(kB[i * 136 + col]) * gs[i]}, a1 = {0.f, 0.f};
            f32x2 b0 = {bf2f(RU[(i + 1) * 136 + col]), bf2f(kB[(i + 1) * 136 + col]) * gs[i + 1]}, b1 = {0.f, 0.f};
#pragma unroll
            for (int jb = 0; jb < (i + 3) / 4; ++jb) {
                const f32x4 la = *(const LAS f32x4*)(Lm + i * 68 + 4 * jb), lb = *(const LAS f32x4*)(Lm + (i + 1) * 68 + 4 * jb);
                if (4 * jb + 0 < i) { a0 -= la[0] * x[4 * jb + 0]; b0 -= lb[0] * x[4 * jb + 0]; }
                if (4 * jb + 1 < i) { a1 -= la[1] * x[4 * jb + 1]; b1 -= lb[1] * x[4 * jb + 1]; }
                if (4 * jb + 2 < i) { a0 -= la[2] * x[4 * jb + 2]; b0 -= lb[2] * x[4 * jb + 2]; }
                if (4 * jb + 3 < i) { a1 -= la[3] * x[4 * jb + 3]; b1 -= lb[3] * x[4 * jb + 3]; }
            }
            x[i] = a0 + a1;
            x[i + 1] = (b0 + b1) - Lm[(i + 1) * 68 + i] * x[i];
        }
#pragma unroll
        for (int i8 = 0; i8 < 8; ++i8) { u32x4 w; w.x = pk(x[8 * i8].x, x[8 * i8 + 1].x); w.y = pk(x[8 * i8 + 2].x, x[8 * i8 + 3].x); w.z = pk(x[8 * i8 + 4].x, x[8 * i8 + 5].x); w.w = pk(x[8 * i8 + 6].x, x[8 * i8 + 7].x);
            *(u32x4*)(oUT + col * 64 + 8 * i8) = w; }
#pragma unroll
        for (int i = 0; i < 64; ++i) oNW[i * 128 + col] = f2bf(-x[i].y);
    } else {
        const int dk = ltid - 128;
#pragma unroll
        for (int g8 = 0; g8 < 8; ++g8) {
            float v[8];
#pragma unroll
            for (int e = 0; e < 8; ++e) { const int t = 8 * g8 + e; v[e] = bf2f(kB[t * 136 + dk]) * __expf(fminf(glast - gs[128 + t], 0.f)); }
            u32x4 w; w.x = pk(v[0], v[1]); w.y = pk(v[2], v[3]); w.z = pk(v[4], v[5]); w.w = pk(v[6], v[7]);
            *(u32x4*)(oKDT + dk * 64 + 8 * g8) = w;
        }
        if (dk == 0) ((float*)(C.ws + WS_EG))[item] = __expf(glast);
    }
    __syncthreads();
}

constexpr int SB_NW = 0, SB_QE = 17408, SB_QK = 34816, SB_KDT = 44032, SB_BYTES = 62464, SB_SSQ = 2 * SB_BYTES;
DI void scan_load(const unsigned char* gp, int tid, u32x4 (&st)[7]) {
    const u32x4* p = (const u32x4*)gp;
    st[0] = p[tid]; st[1] = p[tid + 512];
    st[2] = p[1024 + tid]; st[3] = p[1024 + tid + 512];
    st[4] = p[4096 + tid];
    st[5] = p[2048 + tid]; st[6] = p[2048 + tid + 512];
}
DI void scan_store(LAS unsigned char* buf, int tid, const u32x4 (&st)[7]) {
#pragma unroll
    for (int k = 0; k < 2; ++k) { const int q = tid + 512 * k;
        *(LAS u32x4*)(buf + SB_NW + (q >> 4) * 272 + (q & 15) * 16) = st[k];
        *(LAS u32x4*)(buf + SB_QE + (q >> 4) * 272 + (q & 15) * 16) = st[2 + k];
        *(LAS u32x4*)(buf + SB_KDT + (q >> 3) * 144 + (q & 7) * 16) = st[5 + k]; }
    *(LAS u32x4*)(buf + SB_QK + (tid >> 3) * 144 + (tid & 7) * 16) = st[4];
}
DI bf16x8 lds_a2(const LAS unsigned char* base, int rowbytes, int row, int k0, int fq) {
    const LAS unsigned char* p = base + row * rowbytes + (k0 + 4 * fq) * 2;
    const u32x2 lo = *(const LAS u32x2*)p, hi = *(const LAS u32x2*)(p + 32);
    return mk8(lo.x, lo.y, hi.x, hi.y);
}

DI void gdn_scan_item(LAS unsigned char* lds, const Ctx& C, int l, int sitem) {
    int tid_ = threadIdx.x; asm volatile("" : "+v"(tid_));
    const int tid = tid_, lane = tid & 63, wid = tid >> 6, fr = lane & 15, fq = lane >> 4;
    int ci0, nsteps, rowbase, h, bidx; bool sample;
    if (sitem < 64) { bidx = sitem >> 2; h = sitem & 3; ci0 = bidx * 64; nsteps = 64; rowbase = bidx * 4096; sample = false; }
    else { const int s2 = sitem - 64; bidx = s2 >> 2; h = s2 & 3; ci0 = 1024 + bidx; nsteps = 1; rowbase = NP + bidx * 16; sample = true; }
    const int nvalid = sample ? 16 : 64;
    const int dv = 16 * wid + fr;
    f32x4 S[8];
    if (sample) { const float* s0 = C.st_s + (((size_t)l * 32 + bidx) * 4 + h) * 16384;
#pragma unroll
        for (int m = 0; m < 8; ++m)
#pragma unroll
            for (int j = 0; j < 4; ++j) S[m][j] = s0[(16 * m + 4 * fq + j) * 128 + dv]; }
    else {
#pragma unroll
        for (int m = 0; m < 8; ++m) S[m] = (f32x4){0.f, 0.f, 0.f, 0.f}; }
    const unsigned char* gp0 = C.ws + WS_G;
    const float* EG = (const float*)(C.ws + WS_EG);
    bf16_t* H = (bf16_t*)(C.ws + WS_H);
    u32x4 st[7]; u32x2 ut[4];
    f32x4 nw4[4];
#pragma unroll
    for (int q = 0; q < 4; ++q) nw4[q] = *(const f32x4*)(C.gnw + l * 128 + (tid & 7) * 16 + 4 * q);
    float eg = EG[ci0 * 4 + h];
    {
        const unsigned char* gp = gp0 + (size_t)(ci0 * 4 + h) * GP_ITEM;
        scan_load(gp, tid, st);
#pragma unroll
        for (int m = 0; m < 4; ++m) ut[m] = *(const u32x2*)(gp + 49152 + (dv * 64 + 16 * m + 4 * fq) * 2);
        scan_store(lds, tid, st);
    }
    __syncthreads();
    for (int step = 0; step < nsteps; ++step) {
        const int item = (ci0 + step) * 4 + h;
        LAS unsigned char* buf = lds + (step & 1) * SB_BYTES;
        const bool has_next = step + 1 < nsteps;
        u32x2 utn[4];
        if (has_next) { const unsigned char* gp = gp0 + (size_t)(item + 4) * GP_ITEM; scan_load(gp, tid, st);
#pragma unroll
            for (int m = 0; m < 4; ++m) utn[m] = *(const u32x2*)(gp + 49152 + (dv * 64 + 16 * m + 4 * fq) * 2); }
        else {
#pragma unroll
            for (int m = 0; m < 4; ++m) utn[m] = (u32x2){0u, 0u}; }
        const int ztok = tid >> 3, zc0 = (tid & 7) * 16;
        bf16_t* zp = H + (size_t)(rowbase + step * 64 + ztok) * HLD + C_Z + h * 128 + zc0;
        u32x4 za = {0u, 0u, 0u, 0u}, zb = {0u, 0u, 0u, 0u};
        if (ztok < nvalid) { za = *(const u32x4*)zp; zb = *(const u32x4*)(zp + 8); }
        const float egn = has_next ? EG[item + 4] : 0.f;
        bf16x8 sbv[4];
#pragma unroll
        for (int ks = 0; ks < 4; ++ks) sbv[ks] = mk8(pk(S[2 * ks][0], S[2 * ks][1]), pk(S[2 * ks][2], S[2 * ks][3]), pk(S[2 * ks + 1][0], S[2 * ks + 1][1]), pk(S[2 * ks + 1][2], S[2 * ks + 1][3]));
        f32x4 vn[4], o[4];
#pragma unroll
        for (int m = 0; m < 4; ++m) {
            vn[m] = (f32x4){bflo(ut[m].x), bfhi(ut[m].x), bflo(ut[m].y), bfhi(ut[m].y)};
            o[m] = (f32x4){0.f, 0.f, 0.f, 0.f};
#pragma unroll
            for (int ks = 0; ks < 4; ++ks) {
                vn[m] = mfma16(lds_a2(buf + SB_NW, 272, 16 * m + fr, 32 * ks, fq), sbv[ks], vn[m]);
                o[m] = mfma16(lds_a2(buf + SB_QE, 272, 16 * m + fr, 32 * ks, fq), sbv[ks], o[m]);
            }
            asm volatile("" ::: "memory");
        }
        bf16x8 vb[2];
#pragma unroll
        for (int kt = 0; kt < 2; ++kt) vb[kt] = mk8(pk(vn[2 * kt][0], vn[2 * kt][1]), pk(vn[2 * kt][2], vn[2 * kt][3]), pk(vn[2 * kt + 1][0], vn[2 * kt + 1][1]), pk(vn[2 * kt + 1][2], vn[2 * kt + 1][3]));
#pragma unroll
        for (int m = 0; m < 4; ++m)
#pragma unroll
            for (int kt = 0; kt < 2; ++kt) o[m] = mfma16(lds_a2(buf + SB_QK, 144, 16 * m + fr, 32 * kt, fq), vb[kt], o[m]);
#pragma unroll
        for (int m8 = 0; m8 < 8; ++m8) {
            S[m8] = S[m8] * eg;
#pragma unroll
            for (int kt = 0; kt < 2; ++kt) S[m8] = mfma16(lds_a2(buf + SB_KDT, 144, 16 * m8 + fr, 32 * kt, fq), vb[kt], S[m8]);
            asm volatile("" ::: "memory");
        }
        LAS bf16_t* OB = (LAS bf16_t*)(lds + SB_SSQ);
#pragma unroll
        for (int m = 0; m < 4; ++m)
#pragma unroll
            for (int j = 0; j < 4; ++j) OB[(16 * m + 4 * fq + j) * 136 + dv] = f2bf(o[m][j]);
        if (has_next) scan_store(lds + ((step + 1) & 1) * SB_BYTES, tid, st);
        __syncthreads();
        {
            const u32x4 oa = *(const LAS u32x4*)(OB + ztok * 136 + zc0), ob = *(const LAS u32x4*)(OB + ztok * 136 + zc0 + 8);
            float ov[16], zz[16];
            ov[0] = bflo(oa.x); ov[1] = bfhi(oa.x); ov[2] = bflo(oa.y); ov[3] = bfhi(oa.y); ov[4] = bflo(oa.z); ov[5] = bfhi(oa.z); ov[6] = bflo(oa.w); ov[7] = bfhi(oa.w);
            ov[8] = bflo(ob.x); ov[9] = bfhi(ob.x); ov[10] = bflo(ob.y); ov[11] = bfhi(ob.y); ov[12] = bflo(ob.z); ov[13] = bfhi(ob.z); ov[14] = bflo(ob.w); ov[15] = bfhi(ob.w);
            zz[0] = bflo(za.x); zz[1] = bfhi(za.x); zz[2] = bflo(za.y); zz[3] = bfhi(za.y); zz[4] = bflo(za.z); zz[5] = bfhi(za.z); zz[6] = bflo(za.w); zz[7] = bfhi(za.w);
            zz[8] = bflo(zb.x); zz[9] = bfhi(zb.x); zz[10] = bflo(zb.y); zz[11] = bfhi(zb.y); zz[12] = bflo(zb.z); zz[13] = bfhi(zb.z); zz[14] = bflo(zb.w); zz[15] = bfhi(zb.w);
            float ss = 0.f;
#pragma unroll
            for (int i = 0; i < 16; ++i) ss += ov[i] * ov[i];
            ss += __shfl_xor(ss, 1); ss += __shfl_xor(ss, 2); ss += __shfl_xor(ss, 4);
            const float rstd = rsqrtf(ss * (1.f / 128.f) + 1e-6f);
#pragma unroll
            for (int q = 0; q < 4; ++q) { const f32x4 w4 = nw4[q];
#pragma unroll
                for (int e = 0; e < 4; ++e) { const float z = zz[4 * q + e]; ov[4 * q + e] = ov[4 * q + e] * rstd * w4[e] * (z * sigmoidf_(z)); } }
            if (ztok < nvalid) {
                u32x4 wa, wb;
                wa.x = pk(ov[0], ov[1]); wa.y = pk(ov[2], ov[3]); wa.z = pk(ov[4], ov[5]); wa.w = pk(ov[6], ov[7]);
                wb.x = pk(ov[8], ov[9]); wb.y = pk(ov[10], ov[11]); wb.z = pk(ov[12], ov[13]); wb.w = pk(ov[14], ov[15]);
                bf16_t* op = zp + (C_GV - C_Z); *(u32x4*)op = wa; *(u32x4*)(op + 8) = wb;
            }
        }
        __syncthreads();
#pragma unroll
        for (int m = 0; m < 4; ++m) ut[m] = utn[m];
        eg = egn;
    }
    float* so = C.out + (sample ? O_SGS + (((size_t)l * 32 + bidx) * 4 + h) * 16384 : O_PGS + (((size_t)l * 16 + bidx) * 4 + h) * 16384);
#pragma unroll
    for (int m = 0; m < 8; ++m)
#pragma unroll
        for (int j = 0; j < 4; ++j) so[(16 * m + 4 * fq + j) * 128 + dv] = S[m][j];
    __syncthreads();
}

constexpr int AT_KS = 0, AT_VT = 69632, AT_Q = 144000;
template <int D, int MQ>
DI void attn_loadq(const bf16_t* q0, const bf16_t* q1, int ldq, int lane, bf16x8 (&qf)[MQ][D / 32]) {
    const int fr = lane & 15, fq = lane >> 4;
#pragma unroll
    for (int mq = 0; mq < MQ; ++mq)
#pragma unroll
        for (int ks = 0; ks < D / 32; ++ks) qf[mq][ks] = *(const bf16x8*)((mq ? q1 : q0) + (size_t)fr * ldq + ks * 32 + fq * 8);
}
template <int D, int NT, int MQ>
DI void attn_core(const LAS unsigned char* Ks, const LAS unsigned char* VTs, const bf16x8 (&qf)[MQ][D / 32], bf16_t* o0, bf16_t* o1, int ldo,
                  int kmax, bool has_sink, float sink0, float sink1, float scale, int lane) {
    const int fr = lane & 15, fq = lane >> 4;
    constexpr int KS = D / 32, ND = D / 16, KST = (D + 8) * 2, VST = (NT * 16 + 8) * 2;
    f32x4 s[MQ][NT];
#pragma unroll
    for (int t = 0; t < NT; ++t) {
        bf16x8 kf[KS];
#pragma unroll
        for (int ks = 0; ks < KS; ++ks) kf[ks] = *(const LAS bf16x8*)(Ks + (16 * t + fr) * KST + (32 * ks + 8 * fq) * 2);
#pragma unroll
        for (int mq = 0; mq < MQ; ++mq) { f32x4 a = {0.f, 0.f, 0.f, 0.f};
#pragma unroll
            for (int ks = 0; ks < KS; ++ks) a = mfma16(kf[ks], qf[mq][ks], a);
            s[mq][t] = a; }
        if (t & 1) asm volatile("" ::: "memory");
    }
    unsigned pkd[MQ][NT][2];
#pragma unroll
    for (int mq = 0; mq < MQ; ++mq) {
        const float sink = mq ? sink1 : sink0;
        float mx = has_sink ? sink : -INFINITY;
#pragma unroll
        for (int t = 0; t < NT; ++t)
#pragma unroll
            for (int j = 0; j < 4; ++j) { const int key = 16 * t + 4 * fq + j; const float v = (key < kmax) ? s[mq][t][j] * scale : -INFINITY; s[mq][t][j] = v; mx = fmaxf(mx, v); }
        mx = fmaxf(mx, __shfl_xor(mx, 16)); mx = fmaxf(mx, __shfl_xor(mx, 32));
        float sum = 0.f;
#pragma unroll
        for (int t = 0; t < NT; ++t)
#pragma unroll
            for (int j = 0; j < 4; ++j) { const float p = __expf(s[mq][t][j] - mx); s[mq][t][j] = p; sum += p; }
        sum += __shfl_xor(sum, 16); sum += __shfl_xor(sum, 32);
        if (has_sink) sum += __expf(sink - mx);
        const float inv = 1.f / sum;
#pragma unroll
        for (int t = 0; t < NT; ++t) { pkd[mq][t][0] = pk(s[mq][t][0] * inv, s[mq][t][1] * inv); pkd[mq][t][1] = pk(s[mq][t][2] * inv, s[mq][t][3] * inv); }
    }
    f32x4 o[MQ][ND];
#pragma unroll
    for (int mq = 0; mq < MQ; ++mq)
#pragma unroll
        for (int n = 0; n < ND; ++n) o[mq][n] = (f32x4){0.f, 0.f, 0.f, 0.f};
#pragma unroll
    for (int s2 = 0; s2 < NT / 2; ++s2) {
        bf16x8 pf[MQ];
#pragma unroll
        for (int mq = 0; mq < MQ; ++mq) pf[mq] = mk8(pkd[mq][2 * s2][0], pkd[mq][2 * s2][1], pkd[mq][2 * s2 + 1][0], pkd[mq][2 * s2 + 1][1]);
#pragma unroll
        for (int n = 0; n < ND; ++n) {
            const LAS unsigned char* p = VTs + (16 * n + fr) * VST + (32 * s2 + 4 * fq) * 2;
            const u32x2 lo = *(const LAS u32x2*)p, hi = *(const LAS u32x2*)(p + 32);
            const bf16x8 vf = mk8(lo.x, lo.y, hi.x, hi.y);
#pragma unroll
            for (int mq = 0; mq < MQ; ++mq) o[mq][n] = mfma16(vf, pf[mq], o[mq][n]);
            if ((n & 3) == 3) asm volatile("" ::: "memory");
        }
    }
#pragma unroll
    for (int mq = 0; mq < MQ; ++mq)
#pragma unroll
        for (int n = 0; n < ND; ++n) { u32x2 w; w.x = pk(o[mq][n][0], o[mq][n][1]); w.y = pk(o[mq][n][2], o[mq][n][3]);
            *(u32x2*)((mq ? o1 : o0) + (size_t)fr * ldo + 16 * n + 4 * fq) = w; }
}
template <int D, int NT>
DI void attn_stage(LAS unsigned char* Ks, LAS unsigned char* VTs, const bf16_t* kb, const bf16_t* vb, int ldk, int nrows, int row_off, int tid) {
    constexpr int KST = (D + 8) * 2, VST = (NT * 16 + 8) * 2, PR = D / 8;
    const int total = nrows * PR;
    for (int p = tid; p < total; p += NTHR) { const int r = p / PR, c = p % PR;
        const u32x4 kv = *(const u32x4*)(kb + (size_t)r * ldk + c * 8), vv = *(const u32x4*)(vb + (size_t)r * ldk + c * 8);
        *(LAS u32x4*)(Ks + (row_off + r) * KST + c * 16) = kv;
        LAS bf16_t* vt = (LAS bf16_t*)(VTs + (c * 8) * VST + (row_off + r) * 2);
        vt[0] = (bf16_t)(vv.x & 0xffffu); vt[VST / 2] = (bf16_t)(vv.x >> 16); vt[2 * (VST / 2)] = (bf16_t)(vv.y & 0xffffu); vt[3 * (VST / 2)] = (bf16_t)(vv.y >> 16);
        vt[4 * (VST / 2)] = (bf16_t)(vv.z & 0xffffu); vt[5 * (VST / 2)] = (bf16_t)(vv.z >> 16); vt[6 * (VST / 2)] = (bf16_t)(vv.w & 0xffffu); vt[7 * (VST / 2)] = (bf16_t)(vv.w >> 16); }
}
template <int D, int NT>
DI void attn_zero_vt(LAS unsigned char* VTs, int k0, int tid) {
    constexpr int VST = (NT * 16 + 8) * 2; const int w = NT * 16 - k0;
    for (int p = tid; p < D * w; p += NTHR) { const int d = p / w, k = k0 + p % w; *(LAS bf16_t*)(VTs + d * VST + k * 2) = 0; }
}

constexpr int NC_XAP = 64 * 8, NC_SWP = 16 * 64 * 2, NC_SWS = 32 * 2, NC_XAS = 32 * 4, NC_TOTAL = NC_XAP + NC_SWP + NC_SWS + NC_XAS;

DI void attn_phase(LAS unsigned char* lds, const Ctx& C, int l) {
    int tid_ = threadIdx.x; asm volatile("" : "+v"(tid_));
    const int tid = tid_, lane = tid & 63, wid = __builtin_amdgcn_readfirstlane(tid >> 6);
    const int nw = C.G > 64 ? C.G - 64 : C.G, me = C.G > 64 ? C.c - 64 : C.c;
    if (me < 0) return;
    bf16_t* H = (bf16_t*)(C.ws + WS_H);
    const bf16_t* MK = (const bf16_t*)(C.ws + WS_MKV + (size_t)l * MKV_L);
    LAS unsigned char* Ks = lds + AT_KS; LAS unsigned char* VTs = lds + AT_VT;
    {
        const int lo = (int)((long)me * 2048 / nw), hi = (int)((long)(me + 1) * 2048 / nw);
        int staged = -1;
        bf16x8 qf[1][4], qn[1][4];
        if (lo < hi) { const int pair = lo >> 5; const bf16_t* q0 = H + (size_t)((pair >> 2) * 4096 + (lo & 31) * 128 + wid * 16) * HLD + C_XQ + (pair & 3) * 128; attn_loadq<128, 1>(q0, q0, HLD, lane, qf); }
#pragma unroll 1
        for (int blk = lo; blk < hi; ++blk) {
            const int pair = blk >> 5, b = pair >> 2, hd = pair & 3;
            if (staged != pair) { __syncthreads(); const bf16_t* kb = MK + (size_t)(b * 256) * 1024 + hd * 128; attn_stage<128, 16>(Ks, VTs, kb, kb + 512, 1024, 256, 0, tid); staged = pair; __syncthreads(); }
            const int row0 = b * 4096 + (blk & 31) * 128 + wid * 16;
            bf16_t* q0 = H + (size_t)row0 * HLD + C_XQ + hd * 128;
            { const int nb = blk + 1 < hi ? blk + 1 : blk; const int np = nb >> 5; const bf16_t* qx = H + (size_t)((np >> 2) * 4096 + (nb & 31) * 128 + wid * 16) * HLD + C_XQ + (np & 3) * 128; attn_loadq<128, 1>(qx, qx, HLD, lane, qn); }
            attn_core<128, 16, 1>(Ks, VTs, qf, q0 + (C_GK - C_XQ), q0 + (C_GK - C_XQ), HLD, 256, false, 0.f, 0.f, 0.08838834764831845f, lane);
#pragma unroll
            for (int ks = 0; ks < 4; ++ks) qf[0][ks] = qn[0][ks];
        }
    }
#pragma unroll 1
    for (int ch = me; ch < NC_SWP; ch += nw) {
        const int g = ch & 1, n = (ch >> 1) & 63, b = ch >> 7;
        const int nk = (n >= 2 ? 3 : n + 1) * 64; const int r0 = b * 4096 + (n >= 2 ? n - 2 : 0) * 64;
        const int tb = wid >> 1, hp = wid & 1, hq0 = g * 4 + hp * 2;
        bf16_t* q0 = H + (size_t)(b * 4096 + n * 64 + tb * 16) * HLD + C_SQ + hq0 * 64;
        bf16x8 qs[2][2]; attn_loadq<64, 2>(q0, q0 + 64, HLD, lane, qs);
        const float sk0 = C.sinks[l * 8 + hq0], sk1 = C.sinks[l * 8 + hq0 + 1];
        __syncthreads();
        attn_stage<64, 12>(Ks, VTs, H + (size_t)r0 * HLD + C_SK + g * 64, H + (size_t)r0 * HLD + C_SV + g * 64, HLD, nk, 0, tid);
        if (nk < 192) attn_zero_vt<64, 12>(VTs, nk, tid);
        __syncthreads();
        attn_core<64, 12, 2>(Ks, VTs, qs, q0 + (C_GQ - C_SQ), q0 + 64 + (C_GQ - C_SQ), HLD, nk, true, sk0, sk1, 0.125f, lane);
    }
#pragma unroll 1
    for (int ch0 = me; ch0 < NC_SWS + NC_XAS; ch0 += nw) {
        __syncthreads();
        if (ch0 < NC_SWS) {
            const int g = ch0 & 1, sb = ch0 >> 1; const int row0 = NP + sb * 16;
            const bf16_t* sw = (const bf16_t*)(C.ws + WS_SWC + (size_t)l * SWC_L) + (size_t)(sb * 128) * 256;
            attn_stage<64, 10>(Ks, VTs, sw + g * 64, sw + 128 + g * 64, 256, 128, 0, tid);
            attn_stage<64, 10>(Ks, VTs, H + (size_t)row0 * HLD + C_SK + g * 64, H + (size_t)row0 * HLD + C_SV + g * 64, HLD, 16, 128, tid);
            attn_zero_vt<64, 10>(VTs, 144, tid);
            __syncthreads();
            if (wid < 2) { const int hq0 = g * 4 + wid * 2;
                bf16_t* q0 = H + (size_t)row0 * HLD + C_SQ + hq0 * 64;
                bf16x8 qs[2][2]; attn_loadq<64, 2>(q0, q0 + 64, HLD, lane, qs);
                attn_core<64, 10, 2>(Ks, VTs, qs, q0 + (C_GQ - C_SQ), q0 + 64 + (C_GQ - C_SQ), HLD, 144, true, C.sinks[l * 8 + hq0], C.sinks[l * 8 + hq0 + 1], 0.125f, lane); }
        } else {
            const int ch = ch0 - NC_SWS; const int hd = ch & 3, sb = ch >> 2; const int row0 = NP + sb * 16;
            const bf16_t* kb = MK + (size_t)(4096 + sb * 256) * 1024 + hd * 128;
            attn_stage<128, 16>(Ks, VTs, kb, kb + 512, 1024, 256, 0, tid);
            __syncthreads();
            if (wid == 0) { bf16_t* q0 = H + (size_t)row0 * HLD + C_XQ + hd * 128;
                bf16x8 qx[1][4]; attn_loadq<128, 1>(q0, q0, HLD, lane, qx);
                attn_core<128, 16, 1>(Ks, VTs, qx, q0 + (C_GK - C_XQ), q0 + (C_GK - C_XQ), HLD, 256, false, 0.f, 0.f, 0.08838834764831845f, lane); }
        }
    }
    __syncthreads();
}

#define XB_TMO      128
#define XB_XCNT(j)  (256  + 64 * (j))
#define XB_XSUB(j)  (1280 + 64 * (j))
#define XB_XGEN(j)  (2304 + 64 * (j))
#define XB_TOP      3328
#define XB_TOPGEN   3392
#define XCD_BAR_WORDS 3456
#define XB_SPIN_CAP (1u << 20)
DI unsigned xb_ld(unsigned* p)              { return __hip_atomic_load(p, __ATOMIC_RELAXED, __HIP_MEMORY_SCOPE_AGENT); }
DI unsigned xb_add(unsigned* p, unsigned v) { return __hip_atomic_fetch_add(p, v, __ATOMIC_RELAXED, __HIP_MEMORY_SCOPE_AGENT); }
DI unsigned xb_xcc_id() { return (unsigned)__builtin_amdgcn_s_getreg((3 << 11) | 20) & 0xFu; }
#define XB_SPIN(cond, bar) do { unsigned _sp = 0; while (cond) { __builtin_amdgcn_s_sleep(1); \
    if ((++_sp & 255u) == 0u) { if (xb_ld(&(bar)[XB_TMO])) break; if (_sp > XB_SPIN_CAP) { atomicAdd(&(bar)[XB_TMO], 1u); break; } } } } while (0)
struct XcdBarrier { unsigned* bar; unsigned x; volatile LAS unsigned* st; };
DI XcdBarrier xcd_barrier_post(unsigned* bar, volatile LAS unsigned* st) {
    XcdBarrier b; b.bar = bar; b.x = xb_xcc_id(); b.st = st;
    if (threadIdx.x == 0) (void)xb_add(&bar[XB_XCNT(b.x)], 1u);
    return b;
}
DI void xcd_barrier_complete(unsigned* bar, unsigned x, unsigned& nloc, unsigned& nx) {
    const unsigned G = gridDim.x * gridDim.y * gridDim.z;
    unsigned sum, cnt, mine, sp = 0u;
    for (;;) {
        sum = 0u; cnt = 0u; mine = 0u;
#pragma unroll
        for (unsigned j = 0; j < 16; ++j) { const unsigned c = xb_ld(&bar[XB_XCNT(j)]); sum += c; cnt += (c > 0u) ? 1u : 0u; mine = (j == x) ? c : mine; }
        if (sum == G) break;
        __builtin_amdgcn_s_sleep(1);
        if ((++sp & 255u) == 0u) { if (xb_ld(&bar[XB_TMO])) break; if (sp > XB_SPIN_CAP) { atomicAdd(&bar[XB_TMO], 1u); break; } }
    }
    nloc = mine > 0u ? mine : 1u; nx = cnt > 0u ? cnt : 1u;
}
DI void xcd_barrier(const XcdBarrier& b) {
    asm volatile("s_waitcnt vmcnt(0)" ::: "memory");
    __syncthreads();
    if (threadIdx.x == 0) {
        unsigned* bar = b.bar;
        __builtin_amdgcn_s_waitcnt(0);
        unsigned nloc = b.st[0], nx = b.st[1];
        if (nloc == 0u) { xcd_barrier_complete(bar, b.x, nloc, nx); b.st[0] = nloc; b.st[1] = nx; }
        const unsigned old = xb_add(&bar[XB_XSUB(b.x)], 1u);
        const unsigned gen = old / nloc;
        if (old + 1u == (gen + 1u) * nloc) {
            __builtin_amdgcn_fence(__ATOMIC_RELEASE, "agent");
            asm volatile("s_waitcnt vmcnt(0)" ::: "memory");
            const unsigned og = xb_add(&bar[XB_TOP], 1u);
            const unsigned tg = og / nx;
            if (og + 1u == (tg + 1u) * nx) xb_add(&bar[XB_TOPGEN], 1u);
            else XB_SPIN(xb_ld(&bar[XB_TOPGEN]) == tg, bar);
            __builtin_amdgcn_fence(__ATOMIC_ACQUIRE, "agent");
            xb_add(&bar[XB_XGEN(b.x)], 1u);
            asm volatile("s_waitcnt vmcnt(0)" ::: "memory");
        } else {
            XB_SPIN(xb_ld(&bar[XB_XGEN(b.x)]) == gen, bar);
            __builtin_amdgcn_fence(__ATOMIC_ACQUIRE, "agent");
            asm volatile("s_waitcnt vmcnt(0)" ::: "memory");
        }
    }
    __syncthreads();
}

__global__ void __launch_bounds__(NTHR, 2) hybrid_fwd(Params P) {
    extern __shared__ __attribute__((aligned(16))) unsigned char lds_raw[];
    LAS unsigned char* lds = (LAS unsigned char*)lds_raw;
    cg::grid_group grid = cg::this_grid();
    Ctx C;
    C.xp = P.in[0]; C.xs = P.in[1]; C.st_s = P.in[2]; C.st_conv = P.in[3]; C.csk = P.in[4]; C.csv = P.in[5]; C.cmk = P.in[6]; C.cmv = P.in[7]; C.memp = P.in[8];
    C.w_in = P.in[9]; C.conv_w = P.in[10]; C.a_log = P.in[11]; C.dt_bias = P.in[12]; C.gnw = P.in[13]; C.sinks = P.in[14]; C.w_mkv = P.in[15]; C.w_br = P.in[16]; C.w_o = P.in[17];
    C.ln1g = P.in[18]; C.ln1b = P.in[19]; C.w_up = P.in[20]; C.w_dn = P.in[21]; C.ln2g = P.in[22]; C.ln2b = P.in[23];
    C.out = P.out; C.ws = P.ws; C.G = gridDim.x; C.c = blockIdx.x; C.panel = 0;
    const int lo = P.ph_lo, hi = P.ph_hi;
    volatile LAS unsigned* xst = (volatile LAS unsigned*)(lds + 147440);
    if (threadIdx.x < 2) xst[threadIdx.x] = 0u;
    __syncthreads();
    const XcdBarrier xbar = xcd_barrier_post((unsigned*)(C.ws + WS_CTL) + 4096, xst);
#define RUN(ph) ((ph) >= lo && (ph) < hi)
#define SYNC(ph) do { if (RUN(ph) && RUN((ph) + 1)) { if ((ph) == 0) grid.sync(); else xcd_barrier(xbar); } } while (0)
    if (RUN(0)) p0_convert(lds, C);
    SYNC(0);
#pragma unroll 1
    for (int l = 0; l < 2; ++l) {
        const int pb = 1 + l * 9;
        if (RUN(pb + 0)) { gemm_phase<PH_H>(lds, C, l); gemm_phase<PH_MKV>(lds, C, l); }
        SYNC(pb + 0);
        if (RUN(pb + 1)) { state_copies(C, l); for (int it = C.c; it < N_GITEMS / 2; it += C.G) gdn_pre_pair(lds, C, l, it); }
        SYNC(pb + 1);
        if (RUN(pb + 2)) { for (int it = C.c; it < 192; it += C.G) gdn_scan_item(lds, C, l, it); attn_phase(lds, C, l); gemm_phase<PH_GATE>(lds, C, l); }
        SYNC(pb + 2);
        if (RUN(pb + 3)) { gemm_phase<PH_MERGE>(lds, C, l); gemm_phase<PH_MERGES>(lds, C, l); xcd_barrier(xbar); merge_fixup(C); }
        SYNC(pb + 3);
        if (RUN(pb + 4)) {
#pragma unroll 1
            for (int p = C.c; p < 256; p += C.G) { C.panel = p; ln_zero_stats(lds); gemm_phase<PH_WO>(lds, C, l); ln_panel_sweep(lds, C, p, C.ln1g + l * 1024, C.ln1b + l * 1024, false); }
            gemm_phase<PH_WOS>(lds, C, l); }
        SYNC(pb + 4);
        if (RUN(pb + 5)) ln_sample(C, 4, C.ln1g + l * 1024, C.ln1b + l * 1024, false);
        SYNC(pb + 5);
        if (RUN(pb + 6)) gemm_phase<PH_UP>(lds, C, l);
        SYNC(pb + 6);
        if (RUN(pb + 7)) { gemm_phase<PH_DN>(lds, C, l); gemm_phase<PH_DNS>(lds, C, l); }
        SYNC(pb + 7);
        if (RUN(pb + 8)) { ln_phase(C, C.ln2g + l * 1024, C.ln2b + l * 1024, l == 1); ln_sample(C, 16, C.ln2g + l * 1024, C.ln2b + l * 1024, l == 1); }
        SYNC(pb + 8);
    }
#undef RUN
#undef SYNC
}

extern "C" void kernel_launch(void* const* d_in, const int* in_sizes, int n_in, void* d_out, int out_size, void* d_ws, size_t ws_size, hipStream_t stream) {
    static int grid = 0;
    if (grid == 0) {
        if (n_in != 24 || ws_size < WS_NEED) { fprintf(stderr, "kernel_launch: unexpected n_in %d / ws %zu\n", n_in, ws_size); grid = -1; return; }
        int dev = 0, cus = 0, per_cu = 0;
        hipGetDevice(&dev); hipDeviceGetAttribute(&cus, hipDeviceAttributeMultiprocessorCount, dev);
        if (hipFuncSetAttribute((const void*)hybrid_fwd, hipFuncAttributeMaxDynamicSharedMemorySize, LDS_BYTES) != hipSuccess) { fprintf(stderr, "hipFuncSetAttribute failed\n"); grid = -1; return; }
        if (hipOccupancyMaxActiveBlocksPerMultiprocessor(&per_cu, (const void*)hybrid_fwd, NTHR, LDS_BYTES) != hipSuccess || per_cu < 1) { fprintf(stderr, "occupancy query: %d\n", per_cu); per_cu = 1; }
        (void)hipGetLastError();
        grid = cus * per_cu;
    }
    if (grid < 0) return;
    (void)hipMemsetAsync((char*)d_ws + WS_CTL, 0, 32768, stream);
    Params p{};
    for (int i = 0; i < 24; ++i) p.in[i] = (const float*)d_in[i];
    p.out = (float*)d_out; p.ws = (unsigned char*)d_ws; p.ph_lo = 0; p.ph_hi = 19;
    void* args[] = {&p};
    hipError_t e = hipLaunchCooperativeKernel((const void*)hybrid_fwd, dim3(grid), dim3(NTHR), args, LDS_BYTES, stream);
    if (e != hipSuccess) fprintf(stderr, "cooperative launch failed: %s (grid %d)\n", hipGetErrorString(e), grid);
}
```

```cpp
#include <hip/hip_runtime.h>
#include <hip/hip_cooperative_groups.h>
#include <cstdio>
namespace cg = cooperative_groups;

#define LAS __attribute__((address_space(3)))
#define DI __device__ __forceinline__
typedef unsigned short bf16_t;
typedef short bf16x8 __attribute__((ext_vector_type(8)));
typedef float f32x4 __attribute__((ext_vector_type(4)));
typedef float f32x2 __attribute__((ext_vector_type(2)));
typedef unsigned u32x4 __attribute__((ext_vector_type(4)));
typedef unsigned u32x2 __attribute__((ext_vector_type(2)));
typedef __bf16 bfv2 __attribute__((ext_vector_type(2)));

constexpr int NP = 65536, NS = 512, MT = NP + NS;
constexpr int DM = 1024, HLD = 3584, DFF = 4096, DIN = 6408;
constexpr int C_GQ = 0, C_GK = 512, C_GV = 1024, C_Z = 1536, C_SQ = 2048, C_SK = 2560, C_SV = 2688, C_XQ = 2816, C_A = 3328, C_B = 3332;
constexpr float DN_ALPHA = 1.41421356237f;
constexpr int NTHR = 512;
constexpr int LDS_BYTES = 147456;

constexpr size_t MiB = 1u << 20;
constexpr size_t WS_CTL = 0;
constexpr size_t WS_W = 1 * MiB, WL_BYTES = 36 * MiB;
constexpr size_t WO_IN = 0, WO_G = 7 * MiB, WO_BR = 13 * MiB, WO_O = 16 * MiB, WO_UP = 18 * MiB, WO_DN = 26 * MiB, WO_MKV = 34 * MiB;
constexpr size_t WS_MEMB = 73 * MiB;
constexpr size_t WS_MKV = 81 * MiB, MKV_L = 24 * MiB;
constexpr size_t WS_SWC = 129 * MiB, SWC_L = 2 * MiB;
constexpr size_t WS_XB = 133 * MiB;
constexpr size_t WS_H = 262 * MiB;
constexpr size_t WS_G = 714 * MiB;
constexpr size_t GP_ITEM = 73728;
constexpr int N_GITEMS = (1024 + 32) * 4;
constexpr size_t WS_EG = 1011 * MiB;
constexpr size_t WS_MERGED = 714 * MiB, WS_GS = 843 * MiB, WS_MS = 875 * MiB;
constexpr size_t WS_HID = 262 * MiB;
constexpr size_t WS_GT2S = 1012 * MiB;
constexpr size_t WS_SPM = 1013 * MiB;
constexpr size_t WS_SP = 843 * MiB;
constexpr int LDS_STATS = 131072;
constexpr size_t WS_NEED = 1020 * MiB;

constexpr size_t O_Y = 0, O_PGS = 67633152, O_PGC = 69730304, O_PSK = 69877760, O_PSV = 70402048, O_PMK = 70926336, O_PMV = 75120640,
                 O_SGS = 79314944, O_SGC = 83509248, O_SSK = 83804160, O_SSV = 84852736;

struct Params { const float* in[24]; float* out; unsigned char* ws; int ph_lo, ph_hi; };

struct Ctx {
    const float *xp, *xs, *st_s, *st_conv, *csk, *csv, *cmk, *cmv, *memp, *w_in, *conv_w, *a_log, *dt_bias, *gnw, *sinks, *w_mkv, *w_br, *w_o,
        *ln1g, *ln1b, *w_up, *w_dn, *ln2g, *ln2b;
    float* out; unsigned char* ws;
    int G, c, panel;
};

DI unsigned pk(float a, float b) { f32x2 v = {a, b}; bfv2 r = __builtin_convertvector(v, bfv2); return __builtin_bit_cast(unsigned, r); }
DI bf16_t f2bf(float a) { return (bf16_t)(pk(a, 0.f) & 0xffffu); }
DI float bf2f(bf16_t b) { return __uint_as_float(((unsigned)b) << 16); }
DI float bflo(unsigned w) { return __uint_as_float(w << 16); }
DI float bfhi(unsigned w) { return __uint_as_float(w & 0xffff0000u); }
DI f32x4 mfma16(bf16x8 a, bf16x8 b, f32x4 c) { return __builtin_amdgcn_mfma_f32_16x16x32_bf16(a, b, c, 0, 0, 0); }
DI bf16x8 mk8(unsigned a, unsigned b, unsigned c, unsigned d) { u32x4 v = {a, b, c, d}; return __builtin_bit_cast(bf16x8, v); }
DI float sigmoidf_(float x) { return __builtin_amdgcn_rcpf(1.f + __expf(-x)); }

constexpr int BM = 256, BK = 64, HALF = 128, HTB = HALF * BK * 2, NXCD = 8, WGM = 8;
DI int lds_byte(int r, int c) { const int st = (r >> 4) * 2 + (c >> 5), rr = r & 15, cc = c & 31, ob = rr * 64 + cc * 2; return st * 1024 + (ob ^ (((ob >> 9) & 1) << 5)); }
DI void stage_rc(int b, int& R, int& C) { const int st = b / 1024, sb = b % 1024, swz = sb ^ (((sb >> 9) & 1) << 5); R = (st >> 1) * 16 + swz / 64; C = (st & 1) * 32 + (swz % 64) / 2; }
DI int perm32(int rho) { const int n = rho >> 4, i = rho & 15; return 8 * (i >> 2) + 4 * n + (i & 3); }

enum { K_H = 0, K_MKV = 1, K_GATE = 2, K_BR = 3, K_RES = 4, K_UP = 5, K_PART = 6, K_GATE2 = 7, K_BRP = 8 };
enum { PH_H = 0, PH_MERGE = 1, PH_WO = 2, PH_UP = 3, PH_DN = 4, PH_MKV = 5, PH_WOS = 6, PH_DNS = 7, PH_GATE = 8, PH_MERGES = 9 };
struct UD { const char* A; const char* B; unsigned lda2, ldb2; int nt, kind, pm, pn, aux; };

DI void tile_map(int L, int nM, int nN, int& pm, int& pn) {
    const int nwg = nM * nN; int wgid = L;
    { const int q = nwg / NXCD, r = nwg % NXCD, xcd = wgid % NXCD, off = wgid / NXCD; wgid = (xcd < r ? xcd * (q + 1) : r * (q + 1) + (xcd - r) * q) + off; }
    const int nig = WGM * nN, gid = wgid / nig, fm = gid * WGM, gsz = (nM - fm) < WGM ? (nM - fm) : WGM;
    pm = fm + ((wgid % nig) % gsz); pn = (wgid % nig) / gsz;
}

template <int PH> DI bool get_unit(const Ctx& C, int layer, int i, UD& u) {
    const char* ws = (const char*)C.ws; const char* wl = ws + WS_W + (size_t)layer * WL_BYTES;
    constexpr int NRT = MT / 256;
    if (PH == PH_H) {
        const int L = i * C.G + C.c; if (L >= NRT * 14) return false;
        tile_map(L, NRT, 14, u.pm, u.pn); u.A = ws + WS_XB + (size_t)u.pm * 256 * 2048; u.B = wl + WO_IN + (size_t)u.pn * 256 * 2048; u.lda2 = 2048; u.ldb2 = 2048; u.nt = 16; u.kind = K_H; u.aux = 0; return true;
    } else if (PH == PH_MKV) {
        const int L = i * C.G + ((C.c - 28 + C.G) % C.G); if (L >= 64) return false;
        tile_map(L, 16, 4, u.pm, u.pn); u.A = ws + WS_MEMB + (size_t)u.pm * 256 * 2048; u.B = wl + WO_MKV + (size_t)u.pn * 256 * 2048; u.lda2 = 2048; u.ldb2 = 2048; u.nt = 16; u.kind = K_MKV; u.aux = 0; return true;
    } else if (PH == PH_GATE) {
        int j;
        if (C.G > 64) { constexpr int NSC = 5;
            if (C.c < 64) { if (i >= NSC) return false; j = C.c + i * 64; }
            else { j = 64 * NSC + (C.c - 64) + i * (C.G - 64); } }
        else j = C.c + i * C.G;
        if (j >= NRT * 8 + 8) return false;
        int b;
        if (j < NRT * 8) { int pn8; tile_map(j, NRT, 8, u.pm, pn8); b = pn8 >> 2; u.pn = pn8 & 3; }
        else { const int t = j - NRT * 8; u.pm = 256 + (t >> 2); u.pn = t & 3; b = 2; }
        u.aux = b;
        u.A = ws + WS_XB + (size_t)u.pm * 256 * 2048; u.lda2 = 2048; u.B = wl + WO_G + (size_t)(b * 1024 + u.pn * 256) * 2048; u.ldb2 = 2048; u.nt = 16; u.kind = K_GATE2; return true;
    } else if (PH == PH_MERGE) {
        const int Lt = (i >> 2) * C.G + C.c, sub = i & 3; if (Lt >= 256 * 4) return false;
        tile_map(Lt, 256, 4, u.pm, u.pn);
        if (sub == 0) { u.aux = 2; u.A = ws + WS_XB + (size_t)u.pm * 256 * 2048; u.lda2 = 2048; u.B = wl + WO_G + (size_t)(2 * 1024 + u.pn * 256) * 2048; u.ldb2 = 2048; u.nt = 16; u.kind = K_GATE; }
        else { const int b = sub == 1 ? 2 : (sub == 2 ? 0 : 1); u.aux = b | ((sub - 1) << 4);
            const int colbr = b == 0 ? C_GV : (b == 1 ? C_GQ : C_GK);
            u.A = ws + WS_H + (size_t)u.pm * 256 * (HLD * 2) + colbr * 2; u.lda2 = HLD * 2; u.B = wl + WO_BR + (size_t)b * (1024 * 512 * 2) + (size_t)u.pn * 256 * 1024; u.ldb2 = 1024; u.nt = 8; u.kind = K_BR; }
        return true;
    } else if (PH == PH_MERGES) {
        const int sidx = C.c + i * C.G; if (sidx >= 24) return false; const int t = sidx / 3, b = sidx - 3 * t; u.pm = 256 + (t >> 2); u.pn = t & 3; u.aux = b;
        const int colbr = b == 0 ? C_GV : (b == 1 ? C_GQ : C_GK);
        u.A = ws + WS_H + (size_t)u.pm * 256 * (HLD * 2) + colbr * 2; u.lda2 = HLD * 2; u.B = wl + WO_BR + (size_t)b * (1024 * 512 * 2) + (size_t)u.pn * 256 * 1024; u.ldb2 = 1024; u.nt = 8; u.kind = K_BRP; return true;
    } else if (PH == PH_WO) {
        const int L = i * C.G + C.c; if (L >= 256 * 4) return false; tile_map(L, 256, 4, u.pm, u.pn);
        u.A = ws + WS_MERGED + (size_t)u.pm * 256 * 2048; u.B = wl + WO_O + (size_t)u.pn * 256 * 2048; u.lda2 = 2048; u.ldb2 = 2048; u.nt = 16; u.kind = K_RES; u.aux = 0; return true;
    } else if (PH == PH_WOS) {
        const int sidx = C.c + i * C.G; if (sidx >= 32) return false; const int t = sidx >> 2, ks = sidx & 3; u.pm = 256 + (t >> 2); u.pn = t & 3;
        u.A = ws + WS_MERGED + (size_t)u.pm * 256 * 2048 + ks * 512; u.B = wl + WO_O + (size_t)u.pn * 256 * 2048 + ks * 512; u.lda2 = 2048; u.ldb2 = 2048; u.nt = 4; u.kind = K_PART; u.aux = ks; return true;
    } else if (PH == PH_DNS) {
        const int sidx = C.c + i * C.G; if (sidx >= 128) return false; const int t = sidx >> 4, ks = sidx & 15; u.pm = 256 + (t >> 2); u.pn = t & 3;
        u.A = ws + WS_HID + (size_t)u.pm * 256 * 8192 + ks * 512; u.B = wl + WO_DN + (size_t)u.pn * 256 * 8192 + ks * 512; u.lda2 = 8192; u.ldb2 = 8192; u.nt = 4; u.kind = K_PART; u.aux = ks; return true;
    } else if (PH == PH_UP) {
        const int L = i * C.G + C.c; if (L >= NRT * 16) return false; tile_map(L, NRT, 16, u.pm, u.pn);
        u.A = ws + WS_XB + (size_t)u.pm * 256 * 2048; u.B = wl + WO_UP + (size_t)u.pn * 256 * 2048; u.lda2 = 2048; u.ldb2 = 2048; u.nt = 16; u.kind = K_UP; u.aux = 0; return true;
    } else {
        const int L = i * C.G + C.c; if (L >= 256 * 4) return false; tile_map(L, 256, 4, u.pm, u.pn);
        u.A = ws + WS_HID + (size_t)u.pm * 256 * 8192; u.B = wl + WO_DN + (size_t)u.pn * 256 * 8192; u.lda2 = 8192; u.ldb2 = 8192; u.nt = 64; u.kind = K_RES; u.aux = 0; return true;
    }
}

DI void gemm_epilogue(const Ctx& C, int layer, const f32x4 (&acc)[2][2][4][2], const UD& u, int wr, int wc, int fr, int fq, int tid, LAS unsigned char* lds) {
    unsigned char* ws = C.ws;
    const int row0 = u.pm * BM + wr * 64 + fr, col0 = u.pn * BM + wc * 32 + 8 * fq;
    if (u.kind == K_H) {
        bf16_t* H = (bf16_t*)(ws + WS_H);
#pragma unroll
        for (int ai = 0; ai < 2; ++ai)
#pragma unroll
            for (int m = 0; m < 4; ++m) { bf16_t* rowp = H + (size_t)(row0 + ai * HALF + m * 16) * HLD + col0;
#pragma unroll
                for (int bj = 0; bj < 2; ++bj) { const f32x4 v0 = acc[ai][bj][m][0], v1 = acc[ai][bj][m][1];
                    u32x4 w; w.x = pk(v0[0], v0[1]); w.y = pk(v0[2], v0[3]); w.z = pk(v1[0], v1[1]); w.w = pk(v1[2], v1[3]);
                    *(u32x4*)(rowp + bj * HALF) = w; } }
    } else if (u.kind == K_MKV) {
        bf16_t* MK = (bf16_t*)(ws + WS_MKV + (size_t)layer * MKV_L);
#pragma unroll
        for (int ai = 0; ai < 2; ++ai)
#pragma unroll
            for (int m = 0; m < 4; ++m) { const int r = row0 + ai * HALF + m * 16;
#pragma unroll
                for (int bj = 0; bj < 2; ++bj) { const f32x4 v0 = acc[ai][bj][m][0], v1 = acc[ai][bj][m][1]; const int c = col0 + bj * HALF;
                    u32x4 w; w.x = pk(v0[0], v0[1]); w.y = pk(v0[2], v0[3]); w.z = pk(v1[0], v1[1]); w.w = pk(v1[2], v1[3]);
                    *(u32x4*)(MK + (size_t)r * 1024 + c) = w;
                    float* o = C.out + (c < 512 ? O_PMK : O_PMV) + ((size_t)layer * 4096 + r) * 512 + (c & 511);
                    *(f32x4*)o = v0; *(f32x4*)(o + 4) = v1; } }
    } else if (u.kind == K_GATE) {
        unsigned char* gs = ws + WS_GS + (size_t)C.c * 131072;
#pragma unroll
        for (int ai = 0; ai < 2; ++ai)
#pragma unroll
            for (int m = 0; m < 4; ++m)
#pragma unroll
                for (int bj = 0; bj < 2; ++bj) { const f32x4 v0 = acc[ai][bj][m][0], v1 = acc[ai][bj][m][1]; const int idx = (ai * 4 + m) * 2 + bj;
                    u32x4 w; w.x = pk(sigmoidf_(v0[0]), sigmoidf_(v0[1])); w.y = pk(sigmoidf_(v0[2]), sigmoidf_(v0[3])); w.z = pk(sigmoidf_(v1[0]), sigmoidf_(v1[1])); w.w = pk(sigmoidf_(v1[2]), sigmoidf_(v1[3]));
                    unsigned off = (unsigned)(idx * NTHR + tid) * 16u; asm volatile("" : "+v"(off) :: "memory");
                    *(u32x4*)(gs + off) = w; }
    } else if (u.kind == K_BR) {
        unsigned char* gs = ws + WS_GS + (size_t)C.c * 131072;
        bf16_t* MG = (bf16_t*)(ws + WS_MERGED); const int b = u.aux & 15, mode = u.aux >> 4;
        const bf16_t* GT = (const bf16_t*)C.out + (size_t)b * MT * 1024;
#pragma unroll
        for (int ai = 0; ai < 2; ++ai) {
            unsigned off[8]; u32x4 g[8], p[8];
#pragma unroll
            for (int q = 0; q < 8; ++q) { const int m = q >> 1, bj = q & 1; const int idx = (ai * 4 + m) * 2 + bj; off[q] = (unsigned)(idx * NTHR + tid) * 16u; }
            asm volatile("" : "+v"(off[0]), "+v"(off[1]), "+v"(off[2]), "+v"(off[3]), "+v"(off[4]), "+v"(off[5]), "+v"(off[6]), "+v"(off[7]) :: "memory");
#pragma unroll
            for (int q = 0; q < 8; ++q) { const int m = q >> 1, bj = q & 1; const size_t ro = (size_t)(row0 + ai * HALF + m * 16) * 1024 + col0 + bj * HALF;
                if (b == 2) g[q] = *(const u32x4*)(gs + off[q]); else g[q] = *(const u32x4*)(GT + ro);
                if (mode > 0) p[q] = *(const u32x4*)(MG + ro); }
#pragma unroll
            for (int q = 0; q < 8; ++q) { const int m = q >> 1, bj = q & 1; const size_t ro = (size_t)(row0 + ai * HALF + m * 16) * 1024 + col0 + bj * HALF;
                f32x4 v0 = acc[ai][bj][m][0], v1 = acc[ai][bj][m][1];
                v0[0] *= bflo(g[q].x); v0[1] *= bfhi(g[q].x); v0[2] *= bflo(g[q].y); v0[3] *= bfhi(g[q].y); v1[0] *= bflo(g[q].z); v1[1] *= bfhi(g[q].z); v1[2] *= bflo(g[q].w); v1[3] *= bfhi(g[q].w);
                if (mode > 0) { v0[0] += bflo(p[q].x); v0[1] += bfhi(p[q].x); v0[2] += bflo(p[q].y); v0[3] += bfhi(p[q].y); v1[0] += bflo(p[q].z); v1[1] += bfhi(p[q].z); v1[2] += bflo(p[q].w); v1[3] += bfhi(p[q].w); }
                u32x4 w; w.x = pk(v0[0], v0[1]); w.y = pk(v0[2], v0[3]); w.z = pk(v1[0], v1[1]); w.w = pk(v1[2], v1[3]);
                *(u32x4*)(MG + ro) = w; }
            asm volatile("" ::: "memory");
        }
    } else if (u.kind == K_BRP) {
        const int b = u.aux;
        const bf16_t* GT = b < 2 ? (const bf16_t*)C.out + (size_t)b * MT * 1024 : (const bf16_t*)(ws + WS_GT2S) - (size_t)NP * 1024;
        float* SPM = (float*)(ws + WS_SPM) + (size_t)b * 512 * 1024 - (size_t)NP * 1024;
#pragma unroll
        for (int ai = 0; ai < 2; ++ai)
#pragma unroll
            for (int bj = 0; bj < 2; ++bj) {
                u32x4 g[4];
#pragma unroll
                for (int m = 0; m < 4; ++m) g[m] = *(const u32x4*)(GT + (size_t)(row0 + ai * HALF + m * 16) * 1024 + col0 + bj * HALF);
#pragma unroll
                for (int m = 0; m < 4; ++m) { f32x4 v0 = acc[ai][bj][m][0], v1 = acc[ai][bj][m][1];
                    v0[0] *= bflo(g[m].x); v0[1] *= bfhi(g[m].x); v0[2] *= bflo(g[m].y); v0[3] *= bfhi(g[m].y); v1[0] *= bflo(g[m].z); v1[1] *= bfhi(g[m].z); v1[2] *= bflo(g[m].w); v1[3] *= bfhi(g[m].w);
                    float* o = SPM + (size_t)(row0 + ai * HALF + m * 16) * 1024 + col0 + bj * HALF;
                    *(f32x4*)o = v0; *(f32x4*)(o + 4) = v1; }
                asm volatile("" ::: "memory");
            }
    } else if (u.kind == K_GATE2) {
        bf16_t* GT = u.aux < 2 ? (bf16_t*)C.out + (size_t)u.aux * MT * 1024 : (bf16_t*)(ws + WS_GT2S) - (size_t)NP * 1024;
#pragma unroll
        for (int ai = 0; ai < 2; ++ai)
#pragma unroll
            for (int m = 0; m < 4; ++m) { bf16_t* rowp = GT + (size_t)(row0 + ai * HALF + m * 16) * 1024 + col0;
#pragma unroll
                for (int bj = 0; bj < 2; ++bj) { const f32x4 v0 = acc[ai][bj][m][0], v1 = acc[ai][bj][m][1];
                    u32x4 w; w.x = pk(sigmoidf_(v0[0]), sigmoidf_(v0[1])); w.y = pk(sigmoidf_(v0[2]), sigmoidf_(v0[3])); w.z = pk(sigmoidf_(v1[0]), sigmoidf_(v1[1])); w.w = pk(sigmoidf_(v1[2]), sigmoidf_(v1[3]));
                    *(u32x4*)(rowp + bj * HALF) = w; } }
    } else if (u.kind == K_RES) {
        const bf16_t* XB = (const bf16_t*)(ws + WS_XB); float* Y = C.out + O_Y;
        LAS float* stats = (LAS float*)(lds + LDS_STATS);
#pragma unroll
        for (int ai = 0; ai < 2; ++ai) {
            u32x4 xr[4][2];
#pragma unroll
            for (int m = 0; m < 4; ++m)
#pragma unroll
                for (int bj = 0; bj < 2; ++bj) xr[m][bj] = *(const u32x4*)(XB + (size_t)(row0 + ai * HALF + m * 16) * 1024 + col0 + bj * HALF);
#pragma unroll
            for (int m = 0; m < 4; ++m) { const size_t off = (size_t)(row0 + ai * HALF + m * 16) * 1024 + col0;
                float s1 = 0.f, s2 = 0.f;
#pragma unroll
                for (int bj = 0; bj < 2; ++bj) { f32x4 v0 = acc[ai][bj][m][0], v1 = acc[ai][bj][m][1];
                    const u32x4 x = xr[m][bj];
                    v0[0] += DN_ALPHA * bflo(x.x); v0[1] += DN_ALPHA * bfhi(x.x); v0[2] += DN_ALPHA * bflo(x.y); v0[3] += DN_ALPHA * bfhi(x.y);
                    v1[0] += DN_ALPHA * bflo(x.z); v1[1] += DN_ALPHA * bfhi(x.z); v1[2] += DN_ALPHA * bflo(x.w); v1[3] += DN_ALPHA * bfhi(x.w);
                    s1 += (v0[0] + v0[1]) + (v0[2] + v0[3]) + (v1[0] + v1[1]) + (v1[2] + v1[3]);
                    s2 += (v0[0] * v0[0] + v0[1] * v0[1]) + (v0[2] * v0[2] + v0[3] * v0[3]) + (v1[0] * v1[0] + v1[1] * v1[1]) + (v1[2] * v1[2] + v1[3] * v1[3]);
                    if (u.aux) { *(f32x4*)(Y + off + bj * HALF) = v0; *(f32x4*)(Y + off + bj * HALF + 4) = v1; }
                    else { u32x4 w; w.x = pk(v0[0], v0[1]); w.y = pk(v0[2], v0[3]); w.z = pk(v1[0], v1[1]); w.w = pk(v1[2], v1[3]);
                        *(u32x4*)((bf16_t*)(Y + (size_t)(row0 + ai * HALF + m * 16) * 1024) + col0 + bj * HALF) = w; } }
                s1 += __shfl_xor(s1, 16); s1 += __shfl_xor(s1, 32); s2 += __shfl_xor(s2, 16); s2 += __shfl_xor(s2, 32);
                if (fq == 0 && u.aux) { const int rl = ai * HALF + wr * 64 + m * 16 + fr;
                    __hip_atomic_fetch_add(stats + 2 * rl, s1, __ATOMIC_RELAXED, __HIP_MEMORY_SCOPE_WORKGROUP);
                    __hip_atomic_fetch_add(stats + 2 * rl + 1, s2, __ATOMIC_RELAXED, __HIP_MEMORY_SCOPE_WORKGROUP); } }
            asm volatile("" ::: "memory");
        }
    } else if (u.kind == K_PART) {
        float* SP = (float*)(ws + WS_SP) + (size_t)u.aux * 512 * 1024;
#pragma unroll
        for (int ai = 0; ai < 2; ++ai)
#pragma unroll
            for (int m = 0; m < 4; ++m) { const size_t off = (size_t)(row0 + ai * HALF + m * 16 - NP) * 1024 + col0;
#pragma unroll
                for (int bj = 0; bj < 2; ++bj) { *(f32x4*)(SP + off + bj * HALF) = acc[ai][bj][m][0]; *(f32x4*)(SP + off + bj * HALF + 4) = acc[ai][bj][m][1]; } }
    } else {
        bf16_t* HID = (bf16_t*)(ws + WS_HID);
#pragma unroll
        for (int ai = 0; ai < 2; ++ai)
#pragma unroll
            for (int m = 0; m < 4; ++m) { bf16_t* rowp = HID + (size_t)(row0 + ai * HALF + m * 16) * DFF + col0;
#pragma unroll
                for (int bj = 0; bj < 2; ++bj) { f32x4 v0 = acc[ai][bj][m][0], v1 = acc[ai][bj][m][1];
#pragma unroll
                    for (int j = 0; j < 4; ++j) { const float a = fmaxf(v0[j], 0.f), b = fmaxf(v1[j], 0.f); v0[j] = a * a; v1[j] = b * b; }
                    u32x4 w; w.x = pk(v0[0], v0[1]); w.y = pk(v0[2], v0[3]); w.z = pk(v1[0], v1[1]); w.w = pk(v1[2], v1[3]);
                    *(u32x4*)(rowp + bj * HALF) = w; } }
    }
}

template <int PH>
DI void gemm_phase(LAS unsigned char* lds, const Ctx& C, int layer) {
    int tid_ = threadIdx.x; asm volatile("" : "+v"(tid_));
    const int tid = tid_, wid = __builtin_amdgcn_readfirstlane(tid >> 6), lane = tid & 63, wr = wid >> 2, wc = wid & 3, fr = lane & 15, fq = lane >> 4;
    int R0, C0; stage_rc(tid * 16, R0, C0);
    const int Rb0 = (R0 & ~31) + perm32(R0 & 31);
    const size_t kstep = (size_t)(BK * 2);
    const unsigned ldsw = (unsigned)wid * 1024u;
    const int aoff = lds_byte(wr * 64 + fr, fq * 8), boff = lds_byte(wc * 32 + fr, fq * 8);
#define G_SA(b, h) (((b) * 2 + (h)) * HTB)
#define G_SB(b, h) ((4 + (b) * 2 + (h)) * HTB)
#define G_STAGE(bufoff, gbase, v0, h64) do { \
        __builtin_amdgcn_global_load_lds((const unsigned*)((const char*)(gbase) + (v0)), (LAS unsigned*)(lds + (bufoff) + ldsw), 16, 0, 0); \
        __builtin_amdgcn_global_load_lds((const unsigned*)((const char*)(gbase) + (h64) + (v0)), (LAS unsigned*)(lds + (bufoff) + ldsw + 8192), 16, 0, 0); } while (0)
#define G_LDA(dst, b, h) do { _Pragma("unroll") for (int m = 0; m < 4; ++m) _Pragma("unroll") for (int k = 0; k < 2; ++k) dst[m][k] = *(const LAS bf16x8*)(lds + G_SA(b, h) + aoff + m * 2048 + k * 1024); } while (0)
#define G_LDB(dst, b, h) do { _Pragma("unroll") for (int n = 0; n < 2; ++n) _Pragma("unroll") for (int k = 0; k < 2; ++k) dst[n][k] = *(const LAS bf16x8*)(lds + G_SB(b, h) + boff + n * 2048 + k * 1024); } while (0)
#define G_MMA(ai, bj, At, Bt) do { __builtin_amdgcn_s_setprio(1); _Pragma("unroll") for (int m = 0; m < 4; ++m) _Pragma("unroll") for (int n = 0; n < 2; ++n) _Pragma("unroll") for (int k = 0; k < 2; ++k) \
        acc[ai][bj][m][n] = __builtin_amdgcn_mfma_f32_16x16x32_bf16(Bt[n][k], At[m][k], acc[ai][bj][m][n], 0, 0, 0); __builtin_amdgcn_s_setprio(0); } while (0)
#define G_WAIT_V(n) asm volatile("s_waitcnt vmcnt(" #n ")" ::: "memory")
#define G_WAIT_L(n) asm volatile("s_waitcnt lgkmcnt(" #n ")" ::: "memory")
#define G_BAR __builtin_amdgcn_s_barrier()
#define G_SCHED __builtin_amdgcn_sched_barrier(0)
    UD cur, nxt; int ui = 0;
    if (!get_unit<PH>(C, layer, 0, cur)) return;
    f32x4 acc[2][2][4][2];
#pragma unroll
    for (int a = 0; a < 2; ++a)
#pragma unroll
        for (int b = 0; b < 2; ++b)
#pragma unroll
            for (int m = 0; m < 4; ++m)
#pragma unroll
                for (int n = 0; n < 2; ++n) acc[a][b][m][n] = (f32x4){0.f, 0.f, 0.f, 0.f};
    bf16x8 At[4][2], B0[2][2], B1[2][2];
    const char* cA = cur.A; const char* cB = cur.B;
    unsigned cvA0 = (unsigned)R0 * cur.lda2 + C0 * 2, cvB0 = (unsigned)Rb0 * cur.ldb2 + C0 * 2;
    size_t chA = (size_t)HALF * cur.lda2, chB = (size_t)HALF * cur.ldb2;
    G_STAGE(G_SB(0, 0), cB, cvB0, chB / 2); G_STAGE(G_SA(0, 0), cA, cvA0, chA / 2); G_STAGE(G_SB(0, 1), cB + chB, cvB0, chB / 2); G_STAGE(G_SA(0, 1), cA + chA, cvA0, chA / 2);
    if (wr == 1) G_BAR;
    G_WAIT_V(4); G_BAR;
    G_STAGE(G_SB(1, 0), cB + kstep, cvB0, chB / 2); G_STAGE(G_SA(1, 0), cA + kstep, cvA0, chA / 2); G_STAGE(G_SB(1, 1), cB + chB + kstep, cvB0, chB / 2);
    G_WAIT_V(6); G_BAR;
    for (;;) {
        const bool has_next = get_unit<PH>(C, layer, ui + 1, nxt);
        if (!has_next) nxt = cur;
        const char* nA = nxt.A; const char* nB = nxt.B;
        const unsigned nvA0 = (unsigned)R0 * nxt.lda2 + C0 * 2, nvB0 = (unsigned)Rb0 * nxt.ldb2 + C0 * 2;
        const size_t nhA = (size_t)HALF * nxt.lda2, nhB = (size_t)HALF * nxt.ldb2;
        const int nt = cur.nt;
        for (int t = 0; t < nt; t += 2) {
            const bool last = (t == nt - 2);
            const char* a1 = cA + (size_t)(t + 1) * kstep;
            const char* a2 = last ? nA : cA + (size_t)(t + 2) * kstep; const char* b2 = last ? nB : cB + (size_t)(t + 2) * kstep;
            const char* a3 = a2 + kstep; const char* b3 = b2 + kstep;
            const unsigned sA0 = last ? nvA0 : cvA0, sB0 = last ? nvB0 : cvB0;
            const size_t shA = last ? nhA : chA, shB = last ? nhB : chB;
            G_LDB(B0, 0, 0); G_SCHED; G_LDA(At, 0, 0); G_STAGE(G_SA(1, 1), a1 + chA, cvA0, chA / 2);
            G_WAIT_L(8); G_BAR; G_WAIT_L(0); G_MMA(0, 0, At, B0); G_BAR; G_SCHED;
            G_LDB(B1, 0, 1); G_STAGE(G_SB(0, 0), b2, sB0, shB / 2);
            G_BAR; G_WAIT_L(0); G_MMA(0, 1, At, B1); G_BAR;
            G_LDA(At, 0, 1); G_STAGE(G_SA(0, 0), a2, sA0, shA / 2);
            G_BAR; G_WAIT_L(0); G_MMA(1, 0, At, B0); G_BAR; G_SCHED;
            G_STAGE(G_SB(0, 1), b2 + shB, sB0, shB / 2);
            G_WAIT_V(6); G_BAR; G_MMA(1, 1, At, B1); G_BAR;
            G_LDB(B0, 1, 0); G_SCHED; G_LDA(At, 1, 0); G_STAGE(G_SA(0, 1), a2 + shA, sA0, shA / 2);
            G_WAIT_L(8); G_BAR; G_WAIT_L(0); G_MMA(0, 0, At, B0); G_BAR; G_SCHED;
            G_LDB(B1, 1, 1); G_STAGE(G_SB(1, 0), b3, sB0, shB / 2);
            G_BAR; G_WAIT_L(0); G_MMA(0, 1, At, B1); G_BAR;
            G_LDA(At, 1, 1); G_STAGE(G_SA(1, 0), a3, sA0, shA / 2);
            G_BAR; G_WAIT_L(0); G_MMA(1, 0, At, B0); G_BAR; G_SCHED;
            G_STAGE(G_SB(1, 1), b3 + shB, sB0, shB / 2);
            G_WAIT_V(6); G_BAR; G_MMA(1, 1, At, B1); G_BAR;
        }
        gemm_epilogue(C, layer, acc, cur, wr, wc, fr, fq, tid, lds);
        if (!has_next) break;
#pragma unroll
        for (int a = 0; a < 2; ++a)
#pragma unroll
            for (int b = 0; b < 2; ++b)
#pragma unroll
                for (int m = 0; m < 4; ++m)
#pragma unroll
                    for (int n = 0; n < 2; ++n) acc[a][b][m][n] = (f32x4){0.f, 0.f, 0.f, 0.f};
        cur = nxt; cA = nA; cB = nB; cvA0 = nvA0; cvB0 = nvB0; chA = nhA; chB = nhB; ++ui;
    }
    G_WAIT_V(0);
    if (wr == 0) G_BAR;
    G_BAR;
#undef G_SA
#undef G_SB
#undef G_STAGE
#undef G_LDA
#undef G_LDB
#undef G_MMA
#undef G_WAIT_V
#undef G_WAIT_L
#undef G_BAR
#undef G_SCHED
}

DI void transpose_item(const float* W, int ldw, int srccol, int nvalid, bf16_t* WT, int K, int dstrow, int k0, LAS float* scr, int lane) {
    const int n = lane & 31;
#pragma unroll 16
    for (int i = 0; i < 32; ++i) { const int kk = 2 * i + (lane >> 5); scr[kk * 33 + n] = (n < nvalid) ? W[(size_t)(k0 + kk) * ldw + srccol + n] : 0.f; }
    asm volatile("s_waitcnt lgkmcnt(0)" ::: "memory");
    const int c = lane & 7;
#pragma unroll
    for (int j = 0; j < 4; ++j) { const int nn = (lane >> 3) + 8 * j; const LAS float* s = scr + (8 * c) * 33 + nn;
        u32x4 o; o.x = pk(s[0 * 33], s[1 * 33]); o.y = pk(s[2 * 33], s[3 * 33]); o.z = pk(s[4 * 33], s[5 * 33]); o.w = pk(s[6 * 33], s[7 * 33]);
        *(u32x4*)(WT + (size_t)(dstrow + nn) * K + k0 + 8 * c) = o; }
    asm volatile("s_waitcnt lgkmcnt(0)" ::: "memory");
}

DI void cvt8(const float* src, bf16_t* dst) {
    const f32x4 a = *(const f32x4*)src, b = *(const f32x4*)(src + 4);
    u32x4 w; w.x = pk(a[0], a[1]); w.y = pk(a[2], a[3]); w.z = pk(b[0], b[1]); w.w = pk(b[2], b[3]);
    *(u32x4*)dst = w;
}

DI void p0_convert(LAS unsigned char* lds, const Ctx& C) {
    int tid_ = threadIdx.x; asm volatile("" : "+v"(tid_));
    const int tid = tid_, lane = tid & 63, wid = tid >> 6;
    LAS float* scr = (LAS float*)(lds + wid * 16384);
    const int gw = C.c * 8 + wid, NGW = C.G * 8;
    constexpr int PER_L = 1792 + 1536 + 768 + 512 + 2048 + 2048 + 512;
    for (int it = gw; it < 2 * PER_L; it += NGW) {
        const int l = it / PER_L; int r = it % PER_L;
        unsigned char* wl = C.ws + WS_W + (size_t)l * WL_BYTES;
        if (r < 1792) { const int nb = r >> 4, kb = r & 15, d0 = nb * 32; int src = 0, nv = 32;
            if (d0 < 1536) src = d0; else if (d0 < 3328) src = d0 + 8; else if (d0 == 3328) { src = 1536; nv = 8; } else nv = 0;
            transpose_item(C.w_in + (size_t)l * DM * DIN, DIN, src, nv, (bf16_t*)(wl + WO_IN), 1024, d0, kb * 64, scr, lane); continue; }
        r -= 1792;
        if (r < 1536) { const int nb = r >> 4, kb = r & 15;
            transpose_item(C.w_in + (size_t)l * DM * DIN, DIN, 3336 + nb * 32, 32, (bf16_t*)(wl + WO_G), 1024, nb * 32, kb * 64, scr, lane); continue; }
        r -= 1536;
        if (r < 768) { const int b = r >> 8, rr = r & 255, nb = rr >> 3, kb = rr & 7;
            transpose_item(C.w_br + (size_t)(l * 3 + b) * 512 * 1024, 1024, nb * 32, 32, (bf16_t*)(wl + WO_BR) + (size_t)b * 1024 * 512, 512, nb * 32, kb * 64, scr, lane); continue; }
        r -= 768;
        if (r < 512) { const int nb = r >> 4, kb = r & 15;
            transpose_item(C.w_o + (size_t)l * 1024 * 1024, 1024, nb * 32, 32, (bf16_t*)(wl + WO_O), 1024, nb * 32, kb * 64, scr, lane); continue; }
        r -= 512;
        if (r < 2048) { const int nb = r >> 4, kb = r & 15;
            transpose_item(C.w_up + (size_t)l * 1024 * 4096, 4096, nb * 32, 32, (bf16_t*)(wl + WO_UP), 1024, nb * 32, kb * 64, scr, lane); continue; }
        r -= 2048;
        if (r < 2048) { const int nb = r >> 6, kb = r & 63;
            transpose_item(C.w_dn + (size_t)l * 4096 * 1024, 1024, nb * 32, 32, (bf16_t*)(wl + WO_DN), 4096, nb * 32, kb * 64, scr, lane); continue; }
        r -= 2048;
        { const int nb = r >> 4, kb = r & 15;
            transpose_item(C.w_mkv + (size_t)l * 1024 * 1024, 1024, nb * 32, 32, (bf16_t*)(wl + WO_MKV), 1024, nb * 32, kb * 64, scr, lane); }
    }
    const size_t gt = (size_t)C.c * NTHR + tid, GT = (size_t)C.G * NTHR;
    bf16_t* XB = (bf16_t*)(C.ws + WS_XB);
    {
        const size_t NG = (size_t)MT * 128;
        for (size_t i = gt; i < NG; i += 4 * GT) {
            f32x4 a[4], b[4]; size_t e[4]; bool ok[4];
#pragma unroll
            for (int k = 0; k < 4; ++k) { const size_t ii = i + (size_t)k * GT; ok[k] = ii < NG; e[k] = (ok[k] ? ii : i) * 8;
                const float* sp = e[k] < (size_t)NP * 1024 ? C.xp + e[k] : C.xs + (e[k] - (size_t)NP * 1024);
                a[k] = *(const f32x4*)sp; b[k] = *(const f32x4*)(sp + 4); }
#pragma unroll
            for (int k = 0; k < 4; ++k) if (ok[k]) { u32x4 w; w.x = pk(a[k][0], a[k][1]); w.y = pk(a[k][2], a[k][3]); w.z = pk(b[k][0], b[k][1]); w.w = pk(b[k][2], b[k][3]); *(u32x4*)(XB + e[k]) = w; }
        }
    }
    bf16_t* MB = (bf16_t*)(C.ws + WS_MEMB);
    for (size_t i = gt; i < (size_t)4096 * 128; i += GT) cvt8(C.memp + i * 8, MB + i * 8);
    for (size_t i = gt; i < (size_t)2 * 8192 * 128; i += GT) { const int c8 = (int)(i & 127); const size_t rr = (i >> 7) & 8191, l = i >> 20; const int c = c8 * 8;
        const float* s = (c < 512 ? C.cmk : C.cmv) + ((l * 8192 + rr) * 512 + (c & 511));
        cvt8(s, (bf16_t*)(C.ws + WS_MKV + l * MKV_L) + (4096 + rr) * 1024 + c); }
    for (size_t i = gt; i < (size_t)2 * 4096 * 32; i += GT) { const int c8 = (int)(i & 31); const size_t rr = (i >> 5) & 4095, l = i >> 17; const int c = c8 * 8;
        const float* s = (c < 128 ? C.csk : C.csv) + ((l * 4096 + rr) * 128 + (c & 127));
        cvt8(s, (bf16_t*)(C.ws + WS_SWC + l * SWC_L) + rr * 256 + c); }
}

DI void ln_zero_stats(LAS unsigned char* lds) {
    int tid_ = threadIdx.x; asm volatile("" : "+v"(tid_));
    ((LAS float*)(lds + LDS_STATS))[tid_] = 0.f;
    __syncthreads();
}
DI void ln_panel_sweep(LAS unsigned char* lds, const Ctx& C, int panel, const float* gam, const float* bet, bool final_out) {
    int tid_ = threadIdx.x; asm volatile("" : "+v"(tid_));
    const int tid = tid_, lane = tid & 63, wid = tid >> 6;
    __syncthreads();
    const LAS float* stats = (const LAS float*)(lds + LDS_STATS);
    float* Y = C.out + O_Y; bf16_t* XB = (bf16_t*)(C.ws + WS_XB);
    f32x4 g4[4], b4[4];
#pragma unroll
    for (int j = 0; j < 4; ++j) { g4[j] = ((const f32x4*)gam)[lane + 64 * j]; b4[j] = ((const f32x4*)bet)[lane + 64 * j]; }
#pragma unroll 2
    for (int rr = wid; rr < 256; rr += 8) {
        const int row = panel * 256 + rr;
        const float mean = stats[2 * rr] * (1.f / 1024.f);
        const float var = fmaxf(stats[2 * rr + 1] * (1.f / 1024.f) - mean * mean, 0.f);
        const float rstd = rsqrtf(var + 1e-5f);
        f32x4* yr = (f32x4*)(Y + (size_t)row * 1024) + lane;
#pragma unroll
        for (int j = 0; j < 4; ++j) { const f32x4 o4 = (yr[64 * j] - mean) * rstd * g4[j] + b4[j];
            if (final_out) yr[64 * j] = o4;
            else { u32x2 w; w.x = pk(o4[0], o4[1]); w.y = pk(o4[2], o4[3]); *((u32x2*)(XB + (size_t)row * 1024) + lane + 64 * j) = w; } }
    }
    __syncthreads();
}
DI void ln_sample(const Ctx& C, int nsplit, const float* gam, const float* bet, bool final_out) {
    int tid_ = threadIdx.x; asm volatile("" : "+v"(tid_));
    const int tid = tid_, lane = tid & 63, wid = tid >> 6;
    float* Y = C.out + O_Y; bf16_t* XB = (bf16_t*)(C.ws + WS_XB); const float* SP = (const float*)(C.ws + WS_SP);
    for (int r = C.c * 8 + wid; r < NS; r += C.G * 8) {
        const int row = NP + r;
        f32x4 v[4]; float s = 0.f;
#pragma unroll
        for (int j = 0; j < 4; ++j) { const u32x2 x = *((const u32x2*)(XB + (size_t)row * 1024) + lane + 64 * j);
            v[j] = (f32x4){DN_ALPHA * bflo(x.x), DN_ALPHA * bfhi(x.x), DN_ALPHA * bflo(x.y), DN_ALPHA * bfhi(x.y)}; }
        for (int sp = 0; sp < nsplit; ++sp) { const f32x4* pr = (const f32x4*)(SP + ((size_t)sp * 512 + r) * 1024) + lane;
#pragma unroll
            for (int j = 0; j < 4; ++j) v[j] += pr[64 * j]; }
#pragma unroll
        for (int j = 0; j < 4; ++j) s += (v[j][0] + v[j][1]) + (v[j][2] + v[j][3]);
#pragma unroll
        for (int o = 1; o < 64; o <<= 1) s += __shfl_xor(s, o);
        const float mean = s * (1.f / 1024.f); float s2 = 0.f;
#pragma unroll
        for (int j = 0; j < 4; ++j) { v[j] = v[j] - mean; s2 += (v[j][0] * v[j][0] + v[j][1] * v[j][1]) + (v[j][2] * v[j][2] + v[j][3] * v[j][3]); }
#pragma unroll
        for (int o = 1; o < 64; o <<= 1) s2 += __shfl_xor(s2, o);
        const float rstd = rsqrtf(s2 * (1.f / 1024.f) + 1e-5f);
#pragma unroll
        for (int j = 0; j < 4; ++j) { const f32x4 g4 = ((const f32x4*)gam)[lane + 64 * j], b4 = ((const f32x4*)bet)[lane + 64 * j]; const f32x4 o4 = v[j] * rstd * g4 + b4;
            if (final_out) *((f32x4*)(Y + (size_t)row * 1024) + lane + 64 * j) = o4;
            else { u32x2 w; w.x = pk(o4[0], o4[1]); w.y = pk(o4[2], o4[3]); *((u32x2*)(XB + (size_t)row * 1024) + lane + 64 * j) = w; } }
    }
}

DI void ln_phase(const Ctx& C, const float* gam, const float* bet, bool final_out) {
    int tid_ = threadIdx.x; asm volatile("" : "+v"(tid_));
    const int tid = tid_, lane = tid & 63, wid = tid >> 6;
    float* Y = C.out + O_Y; bf16_t* XB = (bf16_t*)(C.ws + WS_XB);
    f32x4 g4[4], b4[4];
#pragma unroll
    for (int j = 0; j < 4; ++j) { g4[j] = ((const f32x4*)gam)[lane + 64 * j]; b4[j] = ((const f32x4*)bet)[lane + 64 * j]; }
    for (int row0 = (C.c * 8 + wid) * 2; row0 < NP; row0 += C.G * 16) {
        u32x2 raw[2][4];
#pragma unroll
        for (int rr = 0; rr < 2; ++rr)
#pragma unroll
            for (int j = 0; j < 4; ++j) raw[rr][j] = *((const u32x2*)(Y + (size_t)(row0 + rr) * 1024) + lane + 64 * j);
#pragma unroll
        for (int rr = 0; rr < 2; ++rr) {
            const int row = row0 + rr;
            f32x4 v[4]; float s = 0.f;
#pragma unroll
            for (int j = 0; j < 4; ++j) { v[j] = (f32x4){bflo(raw[rr][j].x), bfhi(raw[rr][j].x), bflo(raw[rr][j].y), bfhi(raw[rr][j].y)}; s += (v[j][0] + v[j][1]) + (v[j][2] + v[j][3]); }
#pragma unroll
            for (int o = 1; o < 64; o <<= 1) s += __shfl_xor(s, o);
            const float mean = s * (1.f / 1024.f); float s2 = 0.f;
#pragma unroll
            for (int j = 0; j < 4; ++j) { v[j] = v[j] - mean; s2 += (v[j][0] * v[j][0] + v[j][1] * v[j][1]) + (v[j][2] * v[j][2] + v[j][3] * v[j][3]); }
#pragma unroll
            for (int o = 1; o < 64; o <<= 1) s2 += __shfl_xor(s2, o);
            const float rstd = rsqrtf(s2 * (1.f / 1024.f) + 1e-5f);
#pragma unroll
            for (int j = 0; j < 4; ++j) { const f32x4 o4 = v[j] * rstd * g4[j] + b4[j];
                if (final_out) *((f32x4*)(Y + (size_t)row * 1024) + lane + 64 * j) = o4;
                else { u32x2 w; w.x = pk(o4[0], o4[1]); w.y = pk(o4[2], o4[3]); *((u32x2*)(XB + (size_t)row * 1024) + lane + 64 * j) = w; } }
        }
    }
}
DI void merge_fixup(const Ctx& C) {
    int tid_ = threadIdx.x; asm volatile("" : "+v"(tid_));
    const float* SPM = (const float*)(C.ws + WS_SPM); bf16_t* MG = (bf16_t*)(C.ws + WS_MERGED) + (size_t)NP * 1024;
    for (int i = C.c * NTHR + tid_; i < 512 * 128; i += C.G * NTHR) { const size_t e = (size_t)i * 8;
        f32x4 a = *(const f32x4*)(SPM + e), b = *(const f32x4*)(SPM + e + 4);
#pragma unroll
        for (int k = 1; k < 3; ++k) { a += *(const f32x4*)(SPM + (size_t)k * 512 * 1024 + e); b += *(const f32x4*)(SPM + (size_t)k * 512 * 1024 + e + 4); }
        u32x4 w; w.x = pk(a[0], a[1]); w.y = pk(a[2], a[3]); w.z = pk(b[0], b[1]); w.w = pk(b[2], b[3]);
        *(u32x4*)(MG + e) = w; }
}

DI void state_copies(const Ctx& C, int l) {
    const bf16_t* H = (const bf16_t*)(C.ws + WS_H);
    int tid_ = threadIdx.x; asm volatile("" : "+v"(tid_));
    const size_t gt = (size_t)C.c * NTHR + tid_, GT = (size_t)C.G * NTHR;
    for (size_t i = gt; i < (size_t)16 * 3 * 1536; i += GT) { const int c = (int)(i % 1536); const int j = (int)((i / 1536) % 3), b = (int)(i / 4608);
        C.out[O_PGC + (size_t)l * 73728 + i] = bf2f(H[(size_t)(b * 4096 + 4093 + j) * HLD + c]); }
    for (size_t i = gt; i < (size_t)32 * 3 * 1536; i += GT) { const int c = (int)(i % 1536); const int j = (int)((i / 1536) % 3), sb = (int)(i / 4608);
        C.out[O_SGC + (size_t)l * 147456 + i] = bf2f(H[(size_t)(NP + sb * 16 + 13 + j) * HLD + c]); }
    for (size_t i = gt; i < (size_t)16 * 128 * 128; i += GT) { const int c = (int)(i & 127), r = (int)((i >> 7) & 127), b = (int)(i >> 14);
        const bf16_t* hr = H + (size_t)(b * 4096 + 3968 + r) * HLD;
        C.out[O_PSK + (size_t)l * 262144 + i] = bf2f(hr[C_SK + c]); C.out[O_PSV + (size_t)l * 262144 + i] = bf2f(hr[C_SV + c]); }
    for (size_t i = gt; i < (size_t)32 * 128 * 128; i += GT) { const int c = (int)(i & 127), r = (int)((i >> 7) & 127), sb = (int)(i >> 14);
        float k, v;
        if (r < 112) { const size_t si = (((size_t)l * 32 + sb) * 128 + (r + 16)) * 128 + c; k = C.csk[si]; v = C.csv[si]; }
        else { const bf16_t* hr = H + (size_t)(NP + sb * 16 + (r - 112)) * HLD; k = bf2f(hr[C_SK + c]); v = bf2f(hr[C_SV + c]); }
        C.out[O_SSK + (size_t)l * 524288 + i] = k; C.out[O_SSV + (size_t)l * 524288 + i] = v; }
}

DI void conv_load(const bf16_t* H, int rowbase, int pos0, int tok, bool tv, int col, u32x4 (&ha)[4], u32x4 (&hb)[4]) {
#pragma unroll
    for (int w = 0; w < 4; ++w) {
        const int pos = pos0 + tok - 3 + w;
        ha[w] = (u32x4){0u, 0u, 0u, 0u}; hb[w] = (u32x4){0u, 0u, 0u, 0u};
        if (tv && pos >= 0) { const u32x4* p = (const u32x4*)(H + (size_t)(rowbase + pos) * HLD + col); ha[w] = p[0]; hb[w] = p[1]; }
    }
}
DI void conv_compute(const Ctx& C, int l, int pos0, int tok, bool tv, bool sample, int sb, int col, const LAS float* cwl, const u32x4 (&ha)[4], const u32x4 (&hb)[4], float (&o)[16]) {
#pragma unroll
    for (int i = 0; i < 16; ++i) o[i] = 0.f;
#pragma unroll
    for (int w = 0; w < 4; ++w) {
        const int pos = pos0 + tok - 3 + w;
        float xv[16];
        const u32x4 a = ha[w], b = hb[w];
        xv[0] = bflo(a.x); xv[1] = bfhi(a.x); xv[2] = bflo(a.y); xv[3] = bfhi(a.y); xv[4] = bflo(a.z); xv[5] = bfhi(a.z); xv[6] = bflo(a.w); xv[7] = bfhi(a.w);
        xv[8] = bflo(b.x); xv[9] = bfhi(b.x); xv[10] = bflo(b.y); xv[11] = bfhi(b.y); xv[12] = bflo(b.z); xv[13] = bfhi(b.z); xv[14] = bflo(b.w); xv[15] = bfhi(b.w);
        if (tv && sample && pos < 0) {
            const f32x4* p = (const f32x4*)(C.st_conv + (((size_t)l * 32 + sb) * 3 + (3 + pos)) * 1536 + col);
#pragma unroll
            for (int q = 0; q < 4; ++q) { const f32x4 t = p[q]; xv[4 * q] = t[0]; xv[4 * q + 1] = t[1]; xv[4 * q + 2] = t[2]; xv[4 * q + 3] = t[3]; }
        }
#pragma unroll
        for (int q = 0; q < 4; ++q) { const f32x4 t = *(const LAS f32x4*)(cwl + w * 128 + 4 * q); o[4 * q] += xv[4 * q] * t[0]; o[4 * q + 1] += xv[4 * q + 1] * t[1]; o[4 * q + 2] += xv[4 * q + 2] * t[2]; o[4 * q + 3] += xv[4 * q + 3] * t[3]; }
    }
#pragma unroll
    for (int i = 0; i < 16; ++i) o[i] = tv ? o[i] * sigmoidf_(o[i]) : 0.f;
}

constexpr int PP_HB = 53248;
DI void gdn_pre_pair(LAS unsigned char* lds, const Ctx& C, int l, int pair) {
    int tid_ = threadIdx.x; asm volatile("" : "+v"(tid_));
    const int tid = tid_, lane = tid & 63, wid = tid >> 6, half = tid >> 8, ltid = tid & 255, lw = wid & 3;
    const int h = pair & 3, ci = (pair >> 2) * 2 + half, item = ci * 4 + h;
    int rowbase, pos0, nvalid, sb = 0; bool sample;
    if (ci < 1024) { rowbase = (ci >> 6) * 4096; pos0 = (ci & 63) * 64; nvalid = 64; sample = false; }
    else { sb = ci - 1024; rowbase = NP + sb * 16; pos0 = 0; nvalid = 16; sample = true; }
    const bf16_t* H = (const bf16_t*)(C.ws + WS_H);
    LAS unsigned char* hb = lds + half * PP_HB;
    LAS bf16_t* kB = (LAS bf16_t*)(hb); LAS bf16_t* qB = (LAS bf16_t*)(hb + 17408); LAS float* Lm = (LAS float*)(hb + 17408);
    LAS bf16_t* RU = (LAS bf16_t*)(hb + 34816); LAS float* gs = (LAS float*)(hb + 52224);
    LAS float* cwL = (LAS float*)(lds + 2 * PP_HB);
    unsigned char* gp = C.ws + WS_G + (size_t)item * GP_ITEM;
    bf16_t* oNW = (bf16_t*)gp; bf16_t* oQE = (bf16_t*)(gp + 16384); bf16_t* oKDT = (bf16_t*)(gp + 32768); bf16_t* oUT = (bf16_t*)(gp + 49152); bf16_t* oQK = (bf16_t*)(gp + 65536);
    const int tok = ltid >> 2, grp = ltid & 3, c0 = grp * 32;
    const bool tv = tok < nvalid;
    u32x4 hA[3][2][4], hB[3][2][4];
    conv_load(H, rowbase, pos0, tok, tv, 0 * 512 + h * 128 + c0, hA[0][0], hB[0][0]); conv_load(H, rowbase, pos0, tok, tv, 0 * 512 + h * 128 + c0 + 16, hA[0][1], hB[0][1]);
    if (ltid < 64) {
        float g = 0.f, be = 0.f;
        if (ltid < nvalid) {
            const bf16_t* hr = H + (size_t)(rowbase + pos0 + ltid) * HLD;
            const float a = bf2f(hr[C_A + h]), bb = bf2f(hr[C_B + h]);
            const float x = a + C.dt_bias[l * 4 + h];
            const float sp = fmaxf(x, 0.f) + __logf(1.f + __expf(-fabsf(x)));
            g = -__expf(C.a_log[l * 4 + h]) * sp;
            be = sigmoidf_(bb);
        }
        float c = g;
#pragma unroll
        for (int o = 1; o < 64; o <<= 1) { const float t = __shfl_up(c, o); if (lane >= o) c += t; }
        gs[ltid] = be * __expf(c); gs[64 + ltid] = be; gs[128 + ltid] = c; gs[192 + ltid] = 1.f;
    } else {
        const int idx = half * 192 + (ltid - 64), seg = idx >> 7, ch = idx & 127;
#pragma unroll
        for (int w = 0; w < 4; ++w) cwL[(seg * 4 + w) * 128 + ch] = C.conv_w[((size_t)l * 4 + w) * 1536 + seg * 512 + h * 128 + ch];
    }
    __syncthreads();
    const float gc = gs[128 + tok], glast = gs[128 + 63];
    const float beta = gs[64 + tok], egc = __expf(gc);
#pragma unroll
    for (int seg = 0; seg < 3; ++seg) {
        float va[16], vb[16];
        if (seg < 2) { conv_load(H, rowbase, pos0, tok, tv, (seg + 1) * 512 + h * 128 + c0, hA[seg + 1 < 3 ? seg + 1 : 2][0], hB[seg + 1 < 3 ? seg + 1 : 2][0]);
                       conv_load(H, rowbase, pos0, tok, tv, (seg + 1) * 512 + h * 128 + c0 + 16, hA[seg + 1 < 3 ? seg + 1 : 2][1], hB[seg + 1 < 3 ? seg + 1 : 2][1]); }
        conv_compute(C, l, pos0, tok, tv, sample, sb, seg * 512 + h * 128 + c0, cwL + seg * 512 + c0, hA[seg][0], hB[seg][0], va);
        conv_compute(C, l, pos0, tok, tv, sample, sb, seg * 512 + h * 128 + c0 + 16, cwL + seg * 512 + c0 + 16, hA[seg][1], hB[seg][1], vb);
        float sc = beta;
        if (seg < 2) {
            float ss = 0.f;
#pragma unroll
            for (int i = 0; i < 16; ++i) ss += va[i] * va[i] + vb[i] * vb[i];
            ss += __shfl_xor(ss, 1); ss += __shfl_xor(ss, 2);
            sc = rsqrtf(ss + 1e-6f) * (seg == 0 ? 0.08838834764831845f : 1.f);
        }
#pragma unroll
        for (int i = 0; i < 16; ++i) { va[i] *= sc; vb[i] *= sc; }
        LAS bf16_t* dst = (seg == 0 ? qB : (seg == 1 ? kB : RU)) + tok * 136 + c0;
        u32x4 w0, w1, w2, w3;
        w0.x = pk(va[0], va[1]); w0.y = pk(va[2], va[3]); w0.z = pk(va[4], va[5]); w0.w = pk(va[6], va[7]);
        w1.x = pk(va[8], va[9]); w1.y = pk(va[10], va[11]); w1.z = pk(va[12], va[13]); w1.w = pk(va[14], va[15]);
        w2.x = pk(vb[0], vb[1]); w2.y = pk(vb[2], vb[3]); w2.z = pk(vb[4], vb[5]); w2.w = pk(vb[6], vb[7]);
        w3.x = pk(vb[8], vb[9]); w3.y = pk(vb[10], vb[11]); w3.z = pk(vb[12], vb[13]); w3.w = pk(vb[14], vb[15]);
        *(LAS u32x4*)(dst) = w0; *(LAS u32x4*)(dst + 8) = w1; *(LAS u32x4*)(dst + 16) = w2; *(LAS u32x4*)(dst + 24) = w3;
        if (seg == 0) {
            u32x4 e0, e1, e2, e3;
            e0.x = pk(va[0] * egc, va[1] * egc); e0.y = pk(va[2] * egc, va[3] * egc); e0.z = pk(va[4] * egc, va[5] * egc); e0.w = pk(va[6] * egc, va[7] * egc);
            e1.x = pk(va[8] * egc, va[9] * egc); e1.y = pk(va[10] * egc, va[11] * egc); e1.z = pk(va[12] * egc, va[13] * egc); e1.w = pk(va[14] * egc, va[15] * egc);
            e2.x = pk(vb[0] * egc, vb[1] * egc); e2.y = pk(vb[2] * egc, vb[3] * egc); e2.z = pk(vb[4] * egc, vb[5] * egc); e2.w = pk(vb[6] * egc, vb[7] * egc);
            e3.x = pk(vb[8] * egc, vb[9] * egc); e3.y = pk(vb[10] * egc, vb[11] * egc); e3.z = pk(vb[12] * egc, vb[13] * egc); e3.w = pk(vb[14] * egc, vb[15] * egc);
            bf16_t* qe = oQE + tok * 128 + c0;
            *(u32x4*)(qe) = e0; *(u32x4*)(qe + 8) = e1; *(u32x4*)(qe + 16) = e2; *(u32x4*)(qe + 24) = e3;
        }
        asm volatile("" ::: "memory");
    }
    __syncthreads();
    const int fr = lane & 15, fq = lane >> 4;
    f32x4 ga[2][4];
#pragma unroll
    for (int tk = 0; tk < 2; ++tk) {
        const LAS bf16_t* Xm = tk ? qB : kB;
        bf16x8 xf[4];
#pragma unroll
        for (int ks = 0; ks < 4; ++ks) xf[ks] = *(const LAS bf16x8*)(Xm + (16 * lw + fr) * 136 + 32 * ks + 8 * fq);
#pragma unroll
        for (int nt = 0; nt < 4; ++nt) {
            f32x4 a = {0.f, 0.f, 0.f, 0.f};
#pragma unroll
            for (int ks = 0; ks < 4; ++ks) { const bf16x8 yf = *(const LAS bf16x8*)(kB + (16 * nt + fr) * 136 + 32 * ks + 8 * fq); a = mfma16(xf[ks], yf, a); }
            ga[tk][nt] = a;
        }
    }
    __syncthreads();
#pragma unroll
    for (int nt = 0; nt < 4; ++nt) {
        const int jj = 16 * nt + fr; const float gcj = gs[128 + jj];
#pragma unroll
        for (int j = 0; j < 4; ++j) { const int i = 16 * lw + 4 * fq + j; const float gci = gs[128 + i];
            const float dec = __expf(fminf(gci - gcj, 0.f));
            Lm[i * 68 + jj] = (jj < i) ? gs[64 + i] * ga[0][nt][j] * dec : 0.f;
            oQK[i * 64 + jj] = f2bf((jj <= i) ? ga[1][nt][j] * dec : 0.f); }
    }
    __syncthreads();
    if (lw < 2) {
        const int col = 64 * lw + lane;
        f32x2 x[64];
#pragma unroll
        for (int i = 0; i < 64; i += 2) {
            f32x2 a0 = {bf2f(RU[i * 136 + col]), bf2f(kB[i * 136 + col]) * gs[i]}, a1 = {0.f, 0.f};
            f32x2 b0 = {bf2f(RU[(i + 1) * 136 + col]), bf2f(kB[(i + 1) * 136 + col]) * gs[i + 1]}, b1 = {0.f, 0.f};
#pragma unroll
            for (int jb = 0; jb < (i + 3) / 4; ++jb) {
                const f32x4 la = *(const LAS f32x4*)(Lm + i * 68 + 4 * jb), lb = *(const LAS f32x4*)(Lm + (i + 1) * 68 + 4 * jb);
                if (4 * jb + 0 < i) { a0 -= la[0] * x[4 * jb + 0]; b0 -= lb[0] * x[4 * jb + 0]; }
                if (4 * jb + 1 < i) { a1 -= la[1] * x[4 * jb + 1]; b1 -= lb[1] * x[4 * jb + 1]; }
                if (4 * jb + 2 < i) { a0 -= la[2] * x[4 * jb + 2]; b0 -= lb[2] * x[4 * jb + 2]; }
                if (4 * jb + 3 < i) { a1 -= la[3] * x[4 * jb + 3]; b1 -= lb[3] * x[4 * jb + 3]; }
            }
            x[i] = a0 + a1;
            x[i + 1] = (b0 + b1) - Lm[(i + 1) * 68 + i] * x[i];
        }
#pragma unroll
        for (int i8 = 0; i8 < 8; ++i8) { u32x4 w; w.x = pk(x[8 * i8].x, x[8 * i8 + 1].x); w.y = pk(x[8 * i8 + 2].x, x[8 * i8 + 3].x); w.z = pk(x[8 * i8 + 4].x, x[8 * i8 + 5].x); w.w = pk(x[8 * i8 + 6].x, x[8 * i8 + 7].x);
            *(u32x4*)(oUT + col * 64 + 8 * i8) = w; }
#pragma unroll
        for (int i = 0; i < 64; ++i) oNW[i * 128 + col] = f2bf(-x[i].y);
    } else {
        const int dk = ltid - 128;
#pragma unroll
        for (int g8 = 0; g8 < 8; ++g8) {
            float v[8];
#pragma unroll
            for (int e = 0; e < 8; ++e) { const int t = 8 * g8 + e; v[e] = bf2f(kB[t * 136 + dk]) * __expf(fminf(glast - gs[128 + t], 0.f)); }
            u32x4 w; w.x = pk(v[0], v[1]); w.y = pk(v[2], v[3]); w.z = pk(v[4], v[5]); w.w = pk(v[6], v[7]);
            *(u32x4*)(oKDT + dk * 64 + 8 * g8) = w;
        }
        if (dk == 0) ((float*)(C.ws + WS_EG))[item] = __expf(glast);
    }
    __syncthreads();
}

constexpr int SB_NW = 0, SB_QE = 17408, SB_QK = 34816, SB_KDT = 44032, SB_BYTES = 62464, SB_SSQ = 2 * SB_BYTES;
DI void scan_load(const unsigned char* gp, int tid, u32x4 (&st)[7]) {
    const u32x4* p = (const u32x4*)gp;
    st[0] = p[tid]; st[1] = p[tid + 512];
    st[2] = p[1024 + tid]; st[3] = p[1024 + tid + 512];
    st[4] = p[4096 + tid];
    st[5] = p[2048 + tid]; st[6] = p[2048 + tid + 512];
}
DI void scan_store(LAS unsigned char* buf, int tid, const u32x4 (&st)[7]) {
#pragma unroll
    for (int k = 0; k < 2; ++k) { const int q = tid + 512 * k;
        *(LAS u32x4*)(buf + SB_NW + (q >> 4) * 272 + (q & 15) * 16) = st[k];
        *(LAS u32x4*)(buf + SB_QE + (q >> 4) * 272 + (q & 15) * 16) = st[2 + k];
        *(LAS u32x4*)(buf + SB_KDT + (q >> 3) * 144 + (q & 7) * 16) = st[5 + k]; }
    *(LAS u32x4*)(buf + SB_QK + (tid >> 3) * 144 + (tid & 7) * 16) = st[4];
}
DI bf16x8 lds_a2(const LAS unsigned char* base, int rowbytes, int row, int k0, int fq) {
    const LAS unsigned char* p = base + row * rowbytes + (k0 + 4 * fq) * 2;
    const u32x2 lo = *(const LAS u32x2*)p, hi = *(const LAS u32x2*)(p + 32);
    return mk8(lo.x, lo.y, hi.x, hi.y);
}

DI void gdn_scan_item(LAS unsigned char* lds, const Ctx& C, int l, int sitem) {
    int tid_ = threadIdx.x; asm volatile("" : "+v"(tid_));
    const int tid = tid_, lane = tid & 63, wid = tid >> 6, fr = lane & 15, fq = lane >> 4;
    int ci0, nsteps, rowbase, h, bidx; bool sample;
    if (sitem < 64) { bidx = sitem >> 2; h = sitem & 3; ci0 = bidx * 64; nsteps = 64; rowbase = bidx * 4096; sample = false; }
    else { const int s2 = sitem - 64; bidx = s2 >> 2; h = s2 & 3; ci0 = 1024 + bidx; nsteps = 1; rowbase = NP + bidx * 16; sample = true; }
    const int nvalid = sample ? 16 : 64;
    const int dv = 16 * wid + fr;
    f32x4 S[8];
    if (sample) { const float* s0 = C.st_s + (((size_t)l * 32 + bidx) * 4 + h) * 16384;
#pragma unroll
        for (int m = 0; m < 8; ++m)
#pragma unroll
            for (int j = 0; j < 4; ++j) S[m][j] = s0[(16 * m + 4 * fq + j) * 128 + dv]; }
    else {
#pragma unroll
        for (int m = 0; m < 8; ++m) S[m] = (f32x4){0.f, 0.f, 0.f, 0.f}; }
    const unsigned char* gp0 = C.ws + WS_G;
    const float* EG = (const float*)(C.ws + WS_EG);
    bf16_t* H = (bf16_t*)(C.ws + WS_H);
    u32x4 st[7]; u32x2 ut[4];
    f32x4 nw4[4];
#pragma unroll
    for (int q = 0; q < 4; ++q) nw4[q] = *(const f32x4*)(C.gnw + l * 128 + (tid & 7) * 16 + 4 * q);
    float eg = EG[ci0 * 4 + h];
    {
        const unsigned char* gp = gp0 + (size_t)(ci0 * 4 + h) * GP_ITEM;
        scan_load(gp, tid, st);
#pragma unroll
        for (int m = 0; m < 4; ++m) ut[m] = *(const u32x2*)(gp + 49152 + (dv * 64 + 16 * m + 4 * fq) * 2);
        scan_store(lds, tid, st);
    }
    __syncthreads();
    for (int step = 0; step < nsteps; ++step) {
        const int item = (ci0 + step) * 4 + h;
        LAS unsigned char* buf = lds + (step & 1) * SB_BYTES;
        const bool has_next = step + 1 < nsteps;
        u32x2 utn[4];
        if (has_next) { const unsigned char* gp = gp0 + (size_t)(item + 4) * GP_ITEM; scan_load(gp, tid, st);
#pragma unroll
            for (int m = 0; m < 4; ++m) utn[m] = *(const u32x2*)(gp + 49152 + (dv * 64 + 16 * m + 4 * fq) * 2); }
        else {
#pragma unroll
            for (int m = 0; m < 4; ++m) utn[m] = (u32x2){0u, 0u}; }
        const int ztok = tid >> 3, zc0 = (tid & 7) * 16;
        bf16_t* zp = H + (size_t)(rowbase + step * 64 + ztok) * HLD + C_Z + h * 128 + zc0;
        u32x4 za = {0u, 0u, 0u, 0u}, zb = {0u, 0u, 0u, 0u};
        if (ztok < nvalid) { za = *(const u32x4*)zp; zb = *(const u32x4*)(zp + 8); }
        const float egn = has_next ? EG[item + 4] : 0.f;
        bf16x8 sbv[4];
#pragma unroll
        for (int ks = 0; ks < 4; ++ks) sbv[ks] = mk8(pk(S[2 * ks][0], S[2 * ks][1]), pk(S[2 * ks][2], S[2 * ks][3]), pk(S[2 * ks + 1][0], S[2 * ks + 1][1]), pk(S[2 * ks + 1][2], S[2 * ks + 1][3]));
        f32x4 vn[4], o[4];
#pragma unroll
        for (int m = 0; m < 4; ++m) {
            vn[m] = (f32x4){bflo(ut[m].x), bfhi(ut[m].x), bflo(ut[m].y), bfhi(ut[m].y)};
            o[m] = (f32x4){0.f, 0.f, 0.f, 0.f};
#pragma unroll
            for (int ks = 0; ks < 4; ++ks) {
                vn[m] = mfma16(lds_a2(buf + SB_NW, 272, 16 * m + fr, 32 * ks, fq), sbv[ks], vn[m]);
                o[m] = mfma16(lds_a2(buf + SB_QE, 272, 16 * m + fr, 32 * ks, fq), sbv[ks], o[m]);
            }
            asm volatile("" ::: "memory");
        }
        bf16x8 vb[2];
#pragma unroll
        for (int kt = 0; kt < 2; ++kt) vb[kt] = mk8(pk(vn[2 * kt][0], vn[2 * kt][1]), pk(vn[2 * kt][2], vn[2 * kt][3]), pk(vn[2 * kt + 1][0], vn[2 * kt + 1][1]), pk(vn[2 * kt + 1][2], vn[2 * kt + 1][3]));
#pragma unroll
        for (int m = 0; m < 4; ++m)
#pragma unroll
            for (int kt = 0; kt < 2; ++kt) o[m] = mfma16(lds_a2(buf + SB_QK, 144, 16 * m + fr, 32 * kt, fq), vb[kt], o[m]);
#pragma unroll
        for (int m8 = 0; m8 < 8; ++m8) {
            S[m8] = S[m8] * eg;
#pragma unroll
            for (int kt = 0; kt < 2; ++kt) S[m8] = mfma16(lds_a2(buf + SB_KDT, 144, 16 * m8 + fr, 32 * kt, fq), vb[kt], S[m8]);
            asm volatile("" ::: "memory");
        }
        LAS bf16_t* OB = (LAS bf16_t*)(lds + SB_SSQ);
#pragma unroll
        for (int m = 0; m < 4; ++m)
#pragma unroll
            for (int j = 0; j < 4; ++j) OB[(16 * m + 4 * fq + j) * 136 + dv] = f2bf(o[m][j]);
        if (has_next) scan_store(lds + ((step + 1) & 1) * SB_BYTES, tid, st);
        __syncthreads();
        {
            const u32x4 oa = *(const LAS u32x4*)(OB + ztok * 136 + zc0), ob = *(const LAS u32x4*)(OB + ztok * 136 + zc0 + 8);
            float ov[16], zz[16];
            ov[0] = bflo(oa.x); ov[1] = bfhi(oa.x); ov[2] = bflo(oa.y); ov[3] = bfhi(oa.y); ov[4] = bflo(oa.z); ov[5] = bfhi(oa.z); ov[6] = bflo(oa.w); ov[7] = bfhi(oa.w);
            ov[8] = bflo(ob.x); ov[9] = bfhi(ob.x); ov[10] = bflo(ob.y); ov[11] = bfhi(ob.y); ov[12] = bflo(ob.z); ov[13] = bfhi(ob.z); ov[14] = bflo(ob.w); ov[15] = bfhi(ob.w);
            zz[0] = bflo(za.x); zz[1] = bfhi(za.x); zz[2] = bflo(za.y); zz[3] = bfhi(za.y); zz[4] = bflo(za.z); zz[5] = bfhi(za.z); zz[6] = bflo(za.w); zz[7] = bfhi(za.w);
            zz[8] = bflo(zb.x); zz[9] = bfhi(zb.x); zz[10] = bflo(zb.y); zz[11] = bfhi(zb.y); zz[12] = bflo(zb.z); zz[13] = bfhi(zb.z); zz[14] = bflo(zb.w); zz[15] = bfhi(zb.w);
            float ss = 0.f;
#pragma unroll
            for (int i = 0; i < 16; ++i) ss += ov[i] * ov[i];
            ss += __shfl_xor(ss, 1); ss += __shfl_xor(ss, 2); ss += __shfl_xor(ss, 4);
            const float rstd = rsqrtf(ss * (1.f / 128.f) + 1e-6f);
#pragma unroll
            for (int q = 0; q < 4; ++q) { const f32x4 w4 = nw4[q];
#pragma unroll
                for (int e = 0; e < 4; ++e) { const float z = zz[4 * q + e]; ov[4 * q + e] = ov[4 * q + e] * rstd * w4[e] * (z * sigmoidf_(z)); } }
            if (ztok < nvalid) {
                u32x4 wa, wb;
                wa.x = pk(ov[0], ov[1]); wa.y = pk(ov[2], ov[3]); wa.z = pk(ov[4], ov[5]); wa.w = pk(ov[6], ov[7]);
                wb.x = pk(ov[8], ov[9]); wb.y = pk(ov[10], ov[11]); wb.z = pk(ov[12], ov[13]); wb.w = pk(ov[14], ov[15]);
                bf16_t* op = zp + (C_GV - C_Z); *(u32x4*)op = wa; *(u32x4*)(op + 8) = wb;
            }
        }
        __syncthreads();
#pragma unroll
        for (int m = 0; m < 4; ++m) ut[m] = utn[m];
        eg = egn;
    }
    float* so = C.out + (sample ? O_SGS + (((size_t)l * 32 + bidx) * 4 + h) * 16384 : O_PGS + (((size_t)l * 16 + bidx) * 4 + h) * 16384);
#pragma unroll
    for (int m = 0; m < 8; ++m)
#pragma unroll
        for (int j = 0; j < 4; ++j) so[(16 * m + 4 * fq + j) * 128 + dv] = S[m][j];
    __syncthreads();
}

constexpr int AT_KS = 0, AT_VT = 69632, AT_Q = 144000;
template <int D, int MQ>
DI void attn_loadq(const bf16_t* q0, const bf16_t* q1, int ldq, int lane, bf16x8 (&qf)[MQ][D / 32]) {
    const int fr = lane & 15, fq = lane >> 4;
#pragma unroll
    for (int mq = 0; mq < MQ; ++mq)
#pragma unroll
        for (int ks = 0; ks < D / 32; ++ks) qf[mq][ks] = *(const bf16x8*)((mq ? q1 : q0) + (size_t)fr * ldq + ks * 32 + fq * 8);
}
template <int D, int NT, int MQ>
DI void attn_core(const LAS unsigned char* Ks, const LAS unsigned char* VTs, const bf16x8 (&qf)[MQ][D / 32], bf16_t* o0, bf16_t* o1, int ldo,
                  int kmax, bool has_sink, float sink0, float sink1, float scale, int lane) {
    const int fr = lane & 15, fq = lane >> 4;
    constexpr int KS = D / 32, ND = D / 16, KST = (D + 8) * 2, VST = (NT * 16 + 8) * 2;
    f32x4 s[MQ][NT];
#pragma unroll
    for (int t = 0; t < NT; ++t) {
        bf16x8 kf[KS];
#pragma unroll
        for (int ks = 0; ks < KS; ++ks) kf[ks] = *(const LAS bf16x8*)(Ks + (16 * t + fr) * KST + (32 * ks + 8 * fq) * 2);
#pragma unroll
        for (int mq = 0; mq < MQ; ++mq) { f32x4 a = {0.f, 0.f, 0.f, 0.f};
#pragma unroll
            for (int ks = 0; ks < KS; ++ks) a = mfma16(kf[ks], qf[mq][ks], a);
            s[mq][t] = a; }
        if (t & 1) asm volatile("" ::: "memory");
    }
    unsigned pkd[MQ][NT][2];
#pragma unroll
    for (int mq = 0; mq < MQ; ++mq) {
        const float sink = mq ? sink1 : sink0;
        float mx = has_sink ? sink : -INFINITY;
#pragma unroll
        for (int t = 0; t < NT; ++t)
#pragma unroll
            for (int j = 0; j < 4; ++j) { const int key = 16 * t + 4 * fq + j; const float v = (key < kmax) ? s[mq][t][j] * scale : -INFINITY; s[mq][t][j] = v; mx = fmaxf(mx, v); }
        mx = fmaxf(mx, __shfl_xor(mx, 16)); mx = fmaxf(mx, __shfl_xor(mx, 32));
        float sum = 0.f;
#pragma unroll
        for (int t = 0; t < NT; ++t)
#pragma unroll
            for (int j = 0; j < 4; ++j) { const float p = __expf(s[mq][t][j] - mx); s[mq][t][j] = p; sum += p; }
        sum += __shfl_xor(sum, 16); sum += __shfl_xor(sum, 32);
        if (has_sink) sum += __expf(sink - mx);
        const float inv = 1.f / sum;
#pragma unroll
        for (int t = 0; t < NT; ++t) { pkd[mq][t][0] = pk(s[mq][t][0] * inv, s[mq][t][1] * inv); pkd[mq][t][1] = pk(s[mq][t][2] * inv, s[mq][t][3] * inv); }
    }
    f32x4 o[MQ][ND];
#pragma unroll
    for (int mq = 0; mq < MQ; ++mq)
#pragma unroll
        for (int n = 0; n < ND; ++n) o[mq][n] = (f32x4){0.f, 0.f, 0.f, 0.f};
#pragma unroll
    for (int s2 = 0; s2 < NT / 2; ++s2) {
        bf16x8 pf[MQ];
#pragma unroll
        for (int mq = 0; mq < MQ; ++mq) pf[mq] = mk8(pkd[mq][2 * s2][0], pkd[mq][2 * s2][1], pkd[mq][2 * s2 + 1][0], pkd[mq][2 * s2 + 1][1]);
#pragma unroll
        for (int n = 0; n < ND; ++n) {
            const LAS unsigned char* p = VTs + (16 * n + fr) * VST + (32 * s2 + 4 * fq) * 2;
            const u32x2 lo = *(const LAS u32x2*)p, hi = *(const LAS u32x2*)(p + 32);
            const bf16x8 vf = mk8(lo.x, lo.y, hi.x, hi.y);
#pragma unroll
            for (int mq = 0; mq < MQ; ++mq) o[mq][n] = mfma16(vf, pf[mq], o[mq][n]);
            if ((n & 3) == 3) asm volatile("" ::: "memory");
        }
    }
#pragma unroll
    for (int mq = 0; mq < MQ; ++mq)
#pragma unroll
        for (int n = 0; n < ND; ++n) { u32x2 w; w.x = pk(o[mq][n][0], o[mq][n][1]); w.y = pk(o[mq][n][2], o[mq][n][3]);
            *(u32x2*)((mq ? o1 : o0) + (size_t)fr * ldo + 16 * n + 4 * fq) = w; }
}
template <int D, int NT>
DI void attn_stage(LAS unsigned char* Ks, LAS unsigned char* VTs, const bf16_t* kb, const bf16_t* vb, int ldk, int nrows, int row_off, int tid) {
    constexpr int KST = (D + 8) * 2, VST = (NT * 16 + 8) * 2, PR = D / 8;
    const int total = nrows * PR;
    for (int p = tid; p < total; p += NTHR) { const int r = p / PR, c = p % PR;
        const u32x4 kv = *(const u32x4*)(kb + (size_t)r * ldk + c * 8), vv = *(const u32x4*)(vb + (size_t)r * ldk + c * 8);
        *(LAS u32x4*)(Ks + (row_off + r) * KST + c * 16) = kv;
        LAS bf16_t* vt = (LAS bf16_t*)(VTs + (c * 8) * VST + (row_off + r) * 2);
        vt[0] = (bf16_t)(vv.x & 0xffffu); vt[VST / 2] = (bf16_t)(vv.x >> 16); vt[2 * (VST / 2)] = (bf16_t)(vv.y & 0xffffu); vt[3 * (VST / 2)] = (bf16_t)(vv.y >> 16);
        vt[4 * (VST / 2)] = (bf16_t)(vv.z & 0xffffu); vt[5 * (VST / 2)] = (bf16_t)(vv.z >> 16); vt[6 * (VST / 2)] = (bf16_t)(vv.w & 0xffffu); vt[7 * (VST / 2)] = (bf16_t)(vv.w >> 16); }
}
template <int D, int NT>
DI void attn_zero_vt(LAS unsigned char* VTs, int k0, int tid) {
    constexpr int VST = (NT * 16 + 8) * 2; const int w = NT * 16 - k0;
    for (int p = tid; p < D * w; p += NTHR) { const int d = p / w, k = k0 + p % w; *(LAS bf16_t*)(VTs + d * VST + k * 2) = 0; }
}

constexpr int NC_XAP = 64 * 8, NC_SWP = 16 * 64 * 2, NC_SWS = 32 * 2, NC_XAS = 32 * 4, NC_TOTAL = NC_XAP + NC_SWP + NC_SWS + NC_XAS;

DI void attn_phase(LAS unsigned char* lds, const Ctx& C, int l) {
    int tid_ = threadIdx.x; asm volatile("" : "+v"(tid_));
    const int tid = tid_, lane = tid & 63, wid = __builtin_amdgcn_readfirstlane(tid >> 6);
    const int nw = C.G > 64 ? C.G - 64 : C.G, me = C.G > 64 ? C.c - 64 : C.c;
    if (me < 0) return;
    bf16_t* H = (bf16_t*)(C.ws + WS_H);
    const bf16_t* MK = (const bf16_t*)(C.ws + WS_MKV + (size_t)l * MKV_L);
    LAS unsigned char* Ks = lds + AT_KS; LAS unsigned char* VTs = lds + AT_VT;
    {
        const int lo = (int)((long)me * 2048 / nw), hi = (int)((long)(me + 1) * 2048 / nw);
        int staged = -1;
        bf16x8 qf[1][4], qn[1][4];
        if (lo < hi) { const int pair = lo >> 5; const bf16_t* q0 = H + (size_t)((pair >> 2) * 4096 + (lo & 31) * 128 + wid * 16) * HLD + C_XQ + (pair & 3) * 128; attn_loadq<128, 1>(q0, q0, HLD, lane, qf); }
#pragma unroll 1
        for (int blk = lo; blk < hi; ++blk) {
            const int pair = blk >> 5, b = pair >> 2, hd = pair & 3;
            if (staged != pair) { __syncthreads(); const bf16_t* kb = MK + (size_t)(b * 256) * 1024 + hd * 128; attn_stage<128, 16>(Ks, VTs, kb, kb + 512, 1024, 256, 0, tid); staged = pair; __syncthreads(); }
            const int row0 = b * 4096 + (blk & 31) * 128 + wid * 16;
            bf16_t* q0 = H + (size_t)row0 * HLD + C_XQ + hd * 128;
            { const int nb = blk + 1 < hi ? blk + 1 : blk; const int np = nb >> 5; const bf16_t* qx = H + (size_t)((np >> 2) * 4096 + (nb & 31) * 128 + wid * 16) * HLD + C_XQ + (np & 3) * 128; attn_loadq<128, 1>(qx, qx, HLD, lane, qn); }
            attn_core<128, 16, 1>(Ks, VTs, qf, q0 + (C_GK - C_XQ), q0 + (C_GK - C_XQ), HLD, 256, false, 0.f, 0.f, 0.08838834764831845f, lane);
#pragma unroll
            for (int ks = 0; ks < 4; ++ks) qf[0][ks] = qn[0][ks];
        }
    }
#pragma unroll 1
    for (int ch = me; ch < NC_SWP; ch += nw) {
        const int g = ch & 1, n = (ch >> 1) & 63, b = ch >> 7;
        const int nk = (n >= 2 ? 3 : n + 1) * 64; const int r0 = b * 4096 + (n >= 2 ? n - 2 : 0) * 64;
        const int tb = wid >> 1, hp = wid & 1, hq0 = g * 4 + hp * 2;
        bf16_t* q0 = H + (size_t)(b * 4096 + n * 64 + tb * 16) * HLD + C_SQ + hq0 * 64;
        bf16x8 qs[2][2]; attn_loadq<64, 2>(q0, q0 + 64, HLD, lane, qs);
        const float sk0 = C.sinks[l * 8 + hq0], sk1 = C.sinks[l * 8 + hq0 + 1];
        __syncthreads();
        attn_stage<64, 12>(Ks, VTs, H + (size_t)r0 * HLD + C_SK + g * 64, H + (size_t)r0 * HLD + C_SV + g * 64, HLD, nk, 0, tid);
        if (nk < 192) attn_zero_vt<64, 12>(VTs, nk, tid);
        __syncthreads();
        attn_core<64, 12, 2>(Ks, VTs, qs, q0 + (C_GQ - C_SQ), q0 + 64 + (C_GQ - C_SQ), HLD, nk, true, sk0, sk1, 0.125f, lane);
    }
#pragma unroll 1
    for (int ch0 = me; ch0 < NC_SWS + NC_XAS; ch0 += nw) {
        __syncthreads();
        if (ch0 < NC_SWS) {
            const int g = ch0 & 1, sb = ch0 >> 1; const int row0 = NP + sb * 16;
            const bf16_t* sw = (const bf16_t*)(C.ws + WS_SWC + (size_t)l * SWC_L) + (size_t)(sb * 128) * 256;
            attn_stage<64, 10>(Ks, VTs, sw + g * 64, sw + 128 + g * 64, 256, 128, 0, tid);
            attn_stage<64, 10>(Ks, VTs, H + (size_t)row0 * HLD + C_SK + g * 64, H + (size_t)row0 * HLD + C_SV + g * 64, HLD, 16, 128, tid);
            attn_zero_vt<64, 10>(VTs, 144, tid);
            __syncthreads();
            if (wid < 2) { const int hq0 = g * 4 + wid * 2;
                bf16_t* q0 = H + (size_t)row0 * HLD + C_SQ + hq0 * 64;
                bf16x8 qs[2][2]; attn_loadq<64, 2>(q0, q0 + 64, HLD, lane, qs);
                attn_core<64, 10, 2>(Ks, VTs, qs, q0 + (C_GQ - C_SQ), q0 + 64 + (C_GQ - C_SQ), HLD, 144, true, C.sinks[l * 8 + hq0], C.sinks[l * 8 + hq0 + 1], 0.125f, lane); }
        } else {
            const int ch = ch0 - NC_SWS; const int hd = ch & 3, sb = ch >> 2; const int row0 = NP + sb * 16;
            const bf16_t* kb = MK + (size_t)(4096 + sb * 256) * 1024 + hd * 128;
            attn_stage<128, 16>(Ks, VTs, kb, kb + 512, 1024, 256, 0, tid);
            __syncthreads();
            if (wid == 0) { bf16_t* q0 = H + (size_t)row0 * HLD + C_XQ + hd * 128;
                bf16x8 qx[1][4]; attn_loadq<128, 1>(q0, q0, HLD, lane, qx);
                attn_core<128, 16, 1>(Ks, VTs, qx, q0 + (C_GK - C_XQ), q0 + (C_GK - C_XQ), HLD, 256, false, 0.f, 0.f, 0.08838834764831845f, lane); }
        }
    }
    __syncthreads();
}

#define XB_TMO      128
#define XB_XCNT(j)  (256  + 64 * (j))
#define XB_XSUB(j)  (1280 + 64 * (j))
#define XB_XGEN(j)  (2304 + 64 * (j))
#define XB_TOP      3328
#define XB_TOPGEN   3392
#define XCD_BAR_WORDS 3456
#define XB_SPIN_CAP (1u << 20)
DI unsigned xb_ld(unsigned* p)              { return __hip_atomic_load(p, __ATOMIC_RELAXED, __HIP_MEMORY_SCOPE_AGENT); }
DI unsigned xb_add(unsigned* p, unsigned v) { return __hip_atomic_fetch_add(p, v, __ATOMIC_RELAXED, __HIP_MEMORY_SCOPE_AGENT); }
DI unsigned xb_xcc_id() { return (unsigned)__builtin_amdgcn_s_getreg((3 << 11) | 20) & 0xFu; }
#define XB_SPIN(cond, bar) do { unsigned _sp = 0; while (cond) { __builtin_amdgcn_s_sleep(1); \
    if ((++_sp & 255u) == 0u) { if (xb_ld(&(bar)[XB_TMO])) break; if (_sp > XB_SPIN_CAP) { atomicAdd(&(bar)[XB_TMO], 1u); break; } } } } while (0)
struct XcdBarrier { unsigned* bar; unsigned x; volatile LAS unsigned* st; };
DI XcdBarrier xcd_barrier_post(unsigned* bar, volatile LAS unsigned* st) {
    XcdBarrier b; b.bar = bar; b.x = xb_xcc_id(); b.st = st;
    if (threadIdx.x == 0) (void)xb_add(&bar[XB_XCNT(b.x)], 1u);
    return b;
}
DI void xcd_barrier_complete(unsigned* bar, unsigned x, unsigned& nloc, unsigned& nx) {
    const unsigned G = gridDim.x * gridDim.y * gridDim.z;
    unsigned sum, cnt, mine, sp = 0u;
    for (;;) {
        sum = 0u; cnt = 0u; mine = 0u;
#pragma unroll
        for (unsigned j = 0; j < 16; ++j) { const unsigned c = xb_ld(&bar[XB_XCNT(j)]); sum += c; cnt += (c > 0u) ? 1u : 0u; mine = (j == x) ? c : mine; }
        if (sum == G) break;
        __builtin_amdgcn_s_sleep(1);
        if ((++sp & 255u) == 0u) { if (xb_ld(&bar[XB_TMO])) break; if (sp > XB_SPIN_CAP) { atomicAdd(&bar[XB_TMO], 1u); break; } }
    }
    nloc = mine > 0u ? mine : 1u; nx = cnt > 0u ? cnt : 1u;
}
DI void xcd_barrier(const XcdBarrier& b) {
    asm volatile("s_waitcnt vmcnt(0)" ::: "memory");
    __syncthreads();
    if (threadIdx.x == 0) {
        unsigned* bar = b.bar;
        __builtin_amdgcn_s_waitcnt(0);
        unsigned nloc = b.st[0], nx = b.st[1];
        if (nloc == 0u) { xcd_barrier_complete(bar, b.x, nloc, nx); b.st[0] = nloc; b.st[1] = nx; }
        const unsigned old = xb_add(&bar[XB_XSUB(b.x)], 1u);
        const unsigned gen = old / nloc;
        if (old + 1u == (gen + 1u) * nloc) {
            __builtin_amdgcn_fence(__ATOMIC_RELEASE, "agent");
            asm volatile("s_waitcnt vmcnt(0)" ::: "memory");
            const unsigned og = xb_add(&bar[XB_TOP], 1u);
            const unsigned tg = og / nx;
            if (og + 1u == (tg + 1u) * nx) xb_add(&bar[XB_TOPGEN], 1u);
            else XB_SPIN(xb_ld(&bar[XB_TOPGEN]) == tg, bar);
            __builtin_amdgcn_fence(__ATOMIC_ACQUIRE, "agent");
            xb_add(&bar[XB_XGEN(b.x)], 1u);
            asm volatile("s_waitcnt vmcnt(0)" ::: "memory");
        } else {
            XB_SPIN(xb_ld(&bar[XB_XGEN(b.x)]) == gen, bar);
            __builtin_amdgcn_fence(__ATOMIC_ACQUIRE, "agent");
            asm volatile("s_waitcnt vmcnt(0)" ::: "memory");
        }
    }
    __syncthreads();
}

__global__ void __launch_bounds__(NTHR, 2) hybrid_fwd(Params P) {
    extern __shared__ __attribute__((aligned(16))) unsigned char lds_raw[];
    LAS unsigned char* lds = (LAS unsigned char*)lds_raw;
    cg::grid_group grid = cg::this_grid();
    Ctx C;
    C.xp = P.in[0]; C.xs = P.in[1]; C.st_s = P.in[2]; C.st_conv = P.in[3]; C.csk = P.in[4]; C.csv = P.in[5]; C.cmk = P.in[6]; C.cmv = P.in[7]; C.memp = P.in[8];
    C.w_in = P.in[9]; C.conv_w = P.in[10]; C.a_log = P.in[11]; C.dt_bias = P.in[12]; C.gnw = P.in[13]; C.sinks = P.in[14]; C.w_mkv = P.in[15]; C.w_br = P.in[16]; C.w_o = P.in[17];
    C.ln1g = P.in[18]; C.ln1b = P.in[19]; C.w_up = P.in[20]; C.w_dn = P.in[21]; C.ln2g = P.in[22]; C.ln2b = P.in[23];
    C.out = P.out; C.ws = P.ws; C.G = gridDim.x; C.c = blockIdx.x; C.panel = 0;
    const int lo = P.ph_lo, hi = P.ph_hi;
    volatile LAS unsigned* xst = (volatile LAS unsigned*)(lds + 147440);
    if (threadIdx.x < 2) xst[threadIdx.x] = 0u;
    __syncthreads();
    const XcdBarrier xbar = xcd_barrier_post((unsigned*)(C.ws + WS_CTL) + 4096, xst);
#define RUN(ph) ((ph) >= lo && (ph) < hi)
#define SYNC(ph) do { if (RUN(ph) && RUN((ph) + 1)) { if ((ph) == 0) grid.sync(); else xcd_barrier(xbar); } } while (0)
    if (RUN(0)) p0_convert(lds, C);
    SYNC(0);
#pragma unroll 1
    for (int l = 0; l < 2; ++l) {
        const int pb = 1 + l * 9;
        if (RUN(pb + 0)) { gemm_phase<PH_H>(lds, C, l); gemm_phase<PH_MKV>(lds, C, l); }
        SYNC(pb + 0);
        if (RUN(pb + 1)) { state_copies(C, l); for (int it = C.c; it < N_GITEMS / 2; it += C.G) gdn_pre_pair(lds, C, l, it); }
        SYNC(pb + 1);
        if (RUN(pb + 2)) { for (int it = C.c; it < 192; it += C.G) gdn_scan_item(lds, C, l, it); attn_phase(lds, C, l); gemm_phase<PH_GATE>(lds, C, l); }
        SYNC(pb + 2);
        if (RUN(pb + 3)) { gemm_phase<PH_MERGE>(lds, C, l); gemm_phase<PH_MERGES>(lds, C, l); xcd_barrier(xbar); merge_fixup(C); }
        SYNC(pb + 3);
        if (RUN(pb + 4)) { gemm_phase<PH_WO>(lds, C, l); gemm_phase<PH_WOS>(lds, C, l); }
        SYNC(pb + 4);
        if (RUN(pb + 5)) { ln_phase(C, C.ln1g + l * 1024, C.ln1b + l * 1024, false); ln_sample(C, 4, C.ln1g + l * 1024, C.ln1b + l * 1024, false); }
        SYNC(pb + 5);
        if (RUN(pb + 6)) gemm_phase<PH_UP>(lds, C, l);
        SYNC(pb + 6);
        if (RUN(pb + 7)) { gemm_phase<PH_DN>(lds, C, l); gemm_phase<PH_DNS>(lds, C, l); }
        SYNC(pb + 7);
        if (RUN(pb + 8)) { ln_phase(C, C.ln2g + l * 1024, C.ln2b + l * 1024, l == 1); ln_sample(C, 16, C.ln2g + l * 1024, C.ln2b + l * 1024, l == 1); }
        SYNC(pb + 8);
    }
#undef RUN
#undef SYNC
}

extern "C" void kernel_launch(void* const* d_in, const int* in_sizes, int n_in, void* d_out, int out_size, void* d_ws, size_t ws_size, hipStream_t stream) {
    static int grid = 0;
    if (grid == 0) {
        if (n_in != 24 || ws_size < WS_NEED) { fprintf(stderr, "kernel_launch: unexpected n_in %d / ws %zu\n", n_in, ws_size); grid = -1; return; }
        int dev = 0, cus = 0, per_cu = 0;
        hipGetDevice(&dev); hipDeviceGetAttribute(&cus, hipDeviceAttributeMultiprocessorCount, dev);
        if (hipFuncSetAttribute((const void*)hybrid_fwd, hipFuncAttributeMaxDynamicSharedMemorySize, LDS_BYTES) != hipSuccess) { fprintf(stderr, "hipFuncSetAttribute failed\n"); grid = -1; return; }
        if (hipOccupancyMaxActiveBlocksPerMultiprocessor(&per_cu, (const void*)hybrid_fwd, NTHR, LDS_BYTES) != hipSuccess || per_cu < 1) { fprintf(stderr, "occupancy query: %d\n", per_cu); per_cu = 1; }
        (void)hipGetLastError();
        grid = cus * per_cu;
    }
    if (grid < 0) return;
    (void)hipMemsetAsync((char*)d_ws + WS_CTL, 0, 32768, stream);
    Params p{};
    for (int i = 0; i < 24; ++i) p.in[i] = (const float*)d_in[i];
    p.out = (float*)d_out; p.ws = (unsigned char*)d_ws; p.ph_lo = 0; p.ph_hi = 19;
    void* args[] = {&p};
    hipError_t e = hipLaunchCooperativeKernel((const void*)hybrid_fwd, dim3(grid), dim3(NTHR), args, LDS_BYTES, stream);
    if (e != hipSuccess) fprintf(stderr, "cooperative launch failed: %s (grid %d)\n", hipGetErrorString(e), grid);
}
```

```cpp
#include <hip/hip_runtime.h>
#include <hip/hip_cooperative_groups.h>
#include <cstdio>
namespace cg = cooperative_groups;

#define LAS __attribute__((address_space(3)))
#define DI __device__ __forceinline__
typedef unsigned short bf16_t;
typedef short bf16x8 __attribute__((ext_vector_type(8)));
typedef float f32x4 __attribute__((ext_vector_type(4)));
typedef float f32x2 __attribute__((ext_vector_type(2)));
typedef unsigned u32x4 __attribute__((ext_vector_type(4)));
typedef unsigned u32x2 __attribute__((ext_vector_type(2)));
typedef __bf16 bfv2 __attribute__((ext_vector_type(2)));

constexpr int NP = 65536, NS = 512, MT = NP + NS;
constexpr int DM = 1024, HLD = 3584, DFF = 4096, DIN = 6408;
constexpr int C_GQ = 0, C_GK = 512, C_GV = 1024, C_Z = 1536, C_SQ = 2048, C_SK = 2560, C_SV = 2688, C_XQ = 2816, C_A = 3328, C_B = 3332;
constexpr float DN_ALPHA = 1.41421356237f;
constexpr int NTHR = 512;
constexpr int LDS_BYTES = 147456;

constexpr size_t MiB = 1u << 20;
constexpr size_t WS_CTL = 0;
constexpr size_t WS_W = 1 * MiB, WL_BYTES = 36 * MiB;
constexpr size_t WO_IN = 0, WO_G = 7 * MiB, WO_BR = 13 * MiB, WO_O = 16 * MiB, WO_UP = 18 * MiB, WO_DN = 26 * MiB, WO_MKV = 34 * MiB;
constexpr size_t WS_MEMB = 73 * MiB;
constexpr size_t WS_MKV = 81 * MiB, MKV_L = 24 * MiB;
constexpr size_t WS_SWC = 129 * MiB, SWC_L = 2 * MiB;
constexpr size_t WS_XB = 133 * MiB;
constexpr size_t WS_H = 262 * MiB;
constexpr size_t WS_G = 714 * MiB;
constexpr size_t GP_ITEM = 73728;
constexpr int N_GITEMS = (1024 + 32) * 4;
constexpr size_t WS_EG = 1011 * MiB;
constexpr size_t WS_MERGED = 714 * MiB, WS_GS = 843 * MiB, WS_MS = 875 * MiB;
constexpr size_t WS_HID = 262 * MiB;
constexpr size_t WS_GT2S = 1012 * MiB;
constexpr size_t WS_SPM = 1013 * MiB;
constexpr size_t WS_SP = 843 * MiB;
constexpr int LDS_STATS = 131072;
constexpr size_t WS_NEED = 1020 * MiB;

constexpr size_t O_Y = 0, O_PGS = 67633152, O_PGC = 69730304, O_PSK = 69877760, O_PSV = 70402048, O_PMK = 70926336, O_PMV = 75120640,
                 O_SGS = 79314944, O_SGC = 83509248, O_SSK = 83804160, O_SSV = 84852736;

struct Params { const float* in[24]; float* out; unsigned char* ws; int ph_lo, ph_hi; };

struct Ctx {
    const float *xp, *xs, *st_s, *st_conv, *csk, *csv, *cmk, *cmv, *memp, *w_in, *conv_w, *a_log, *dt_bias, *gnw, *sinks, *w_mkv, *w_br, *w_o,
        *ln1g, *ln1b, *w_up, *w_dn, *ln2g, *ln2b;
    float* out; unsigned char* ws;
    int G, c, panel;
};

DI unsigned pk(float a, float b) { f32x2 v = {a, b}; bfv2 r = __builtin_convertvector(v, bfv2); return __builtin_bit_cast(unsigned, r); }
DI bf16_t f2bf(float a) { return (bf16_t)(pk(a, 0.f) & 0xffffu); }
DI float bf2f(bf16_t b) { return __uint_as_float(((unsigned)b) << 16); }
DI float bflo(unsigned w) { return __uint_as_float(w << 16); }
DI float bfhi(unsigned w) { return __uint_as_float(w & 0xffff0000u); }
DI f32x4 mfma16(bf16x8 a, bf16x8 b, f32x4 c) { return __builtin_amdgcn_mfma_f32_16x16x32_bf16(a, b, c, 0, 0, 0); }
DI bf16x8 mk8(unsigned a, unsigned b, unsigned c, unsigned d) { u32x4 v = {a, b, c, d}; return __builtin_bit_cast(bf16x8, v); }
DI void lds_barrier() { asm volatile("s_waitcnt lgkmcnt(0)" ::: "memory"); __builtin_amdgcn_s_barrier(); asm volatile("" ::: "memory"); }
DI float sigmoidf_(float x) { return __builtin_amdgcn_rcpf(1.f + __expf(-x)); }

constexpr int BM = 256, BK = 64, HALF = 128, HTB = HALF * BK * 2, NXCD = 8, WGM = 8;
DI int lds_byte(int r, int c) { const int st = (r >> 4) * 2 + (c >> 5), rr = r & 15, cc = c & 31, ob = rr * 64 + cc * 2; return st * 1024 + (ob ^ (((ob >> 9) & 1) << 5)); }
DI void stage_rc(int b, int& R, int& C) { const int st = b / 1024, sb = b % 1024, swz = sb ^ (((sb >> 9) & 1) << 5); R = (st >> 1) * 16 + swz / 64; C = (st & 1) * 32 + (swz % 64) / 2; }
DI int perm32(int rho) { const int n = rho >> 4, i = rho & 15; return 8 * (i >> 2) + 4 * n + (i & 3); }

enum { K_H = 0, K_MKV = 1, K_GATE = 2, K_BR = 3, K_RES = 4, K_UP = 5, K_PART = 6, K_GATE2 = 7, K_BRP = 8 };
enum { PH_H = 0, PH_MERGE = 1, PH_WO = 2, PH_UP = 3, PH_DN = 4, PH_MKV = 5, PH_WOS = 6, PH_DNS = 7, PH_GATE = 8, PH_MERGES = 9 };
struct UD { const char* A; const char* B; unsigned lda2, ldb2; int nt, kind, pm, pn, aux; };

DI void tile_map(int L, int nM, int nN, int& pm, int& pn) {
    const int nwg = nM * nN; int wgid = L;
    { const int q = nwg / NXCD, r = nwg % NXCD, xcd = wgid % NXCD, off = wgid / NXCD; wgid = (xcd < r ? xcd * (q + 1) : r * (q + 1) + (xcd - r) * q) + off; }
    const int nig = WGM * nN, gid = wgid / nig, fm = gid * WGM, gsz = (nM - fm) < WGM ? (nM - fm) : WGM;
    pm = fm + ((wgid % nig) % gsz); pn = (wgid % nig) / gsz;
}

template <int PH> DI bool get_unit(const Ctx& C, int layer, int i, UD& u) {
    const char* ws = (const char*)C.ws; const char* wl = ws + WS_W + (size_t)layer * WL_BYTES;
    constexpr int NRT = MT / 256;
    if (PH == PH_H) {
        const int L = i * C.G + C.c; if (L >= NRT * 14) return false;
        tile_map(L, NRT, 14, u.pm, u.pn); u.A = ws + WS_XB + (size_t)u.pm * 256 * 2048; u.B = wl + WO_IN + (size_t)u.pn * 256 * 2048; u.lda2 = 2048; u.ldb2 = 2048; u.nt = 16; u.kind = K_H; u.aux = 0; return true;
    } else if (PH == PH_MKV) {
        const int L = i * C.G + ((C.c - 28 + C.G) % C.G); if (L >= 64) return false;
        tile_map(L, 16, 4, u.pm, u.pn); u.A = ws + WS_MEMB + (size_t)u.pm * 256 * 2048; u.B = wl + WO_MKV + (size_t)u.pn * 256 * 2048; u.lda2 = 2048; u.ldb2 = 2048; u.nt = 16; u.kind = K_MKV; u.aux = 0; return true;
    } else if (PH == PH_GATE) {
        int j;
        if (C.G > 64) { constexpr int NSC = 5;
            if (C.c < 64) { if (i >= NSC) return false; j = C.c + i * 64; }
            else { j = 64 * NSC + (C.c - 64) + i * (C.G - 64); } }
        else j = C.c + i * C.G;
        if (j >= NRT * 8 + 8) return false;
        int b;
        if (j < NRT * 8) { int pn8; tile_map(j, NRT, 8, u.pm, pn8); b = pn8 >> 2; u.pn = pn8 & 3; }
        else { const int t = j - NRT * 8; u.pm = 256 + (t >> 2); u.pn = t & 3; b = 2; }
        u.aux = b;
        u.A = ws + WS_XB + (size_t)u.pm * 256 * 2048; u.lda2 = 2048; u.B = wl + WO_G + (size_t)(b * 1024 + u.pn * 256) * 2048; u.ldb2 = 2048; u.nt = 16; u.kind = K_GATE2; return true;
    } else if (PH == PH_MERGE) {
        const int Lt = (i >> 2) * C.G + C.c, sub = i & 3; if (Lt >= 256 * 4) return false;
        tile_map(Lt, 256, 4, u.pm, u.pn);
        if (sub == 0) { u.aux = 2; u.A = ws + WS_XB + (size_t)u.pm * 256 * 2048; u.lda2 = 2048; u.B = wl + WO_G + (size_t)(2 * 1024 + u.pn * 256) * 2048; u.ldb2 = 2048; u.nt = 16; u.kind = K_GATE; }
        else { const int b = sub == 1 ? 2 : (sub == 2 ? 0 : 1); u.aux = b | ((sub - 1) << 4);
            const int colbr = b == 0 ? C_GV : (b == 1 ? C_GQ : C_GK);
            u.A = ws + WS_H + (size_t)u.pm * 256 * (HLD * 2) + colbr * 2; u.lda2 = HLD * 2; u.B = wl + WO_BR + (size_t)b * (1024 * 512 * 2) + (size_t)u.pn * 256 * 1024; u.ldb2 = 1024; u.nt = 8; u.kind = K_BR; }
        return true;
    } else if (PH == PH_MERGES) {
        const int sidx = C.c + i * C.G; if (sidx >= 24) return false; const int t = sidx / 3, b = sidx - 3 * t; u.pm = 256 + (t >> 2); u.pn = t & 3; u.aux = b;
        const int colbr = b == 0 ? C_GV : (b == 1 ? C_GQ : C_GK);
        u.A = ws + WS_H + (size_t)u.pm * 256 * (HLD * 2) + colbr * 2; u.lda2 = HLD * 2; u.B = wl + WO_BR + (size_t)b * (1024 * 512 * 2) + (size_t)u.pn * 256 * 1024; u.ldb2 = 1024; u.nt = 8; u.kind = K_BRP; return true;
    } else if (PH == PH_WO) {
        const int L = i * C.G + C.c; if (L >= 256 * 4) return false; tile_map(L, 256, 4, u.pm, u.pn);
        u.A = ws + WS_MERGED + (size_t)u.pm * 256 * 2048; u.B = wl + WO_O + (size_t)u.pn * 256 * 2048; u.lda2 = 2048; u.ldb2 = 2048; u.nt = 16; u.kind = K_RES; u.aux = 0; return true;
    } else if (PH == PH_WOS) {
        const int sidx = C.c + i * C.G; if (sidx >= 32) return false; const int t = sidx >> 2, ks = sidx & 3; u.pm = 256 + (t >> 2); u.pn = t & 3;
        u.A = ws + WS_MERGED + (size_t)u.pm * 256 * 2048 + ks * 512; u.B = wl + WO_O + (size_t)u.pn * 256 * 2048 + ks * 512; u.lda2 = 2048; u.ldb2 = 2048; u.nt = 4; u.kind = K_PART; u.aux = ks; return true;
    } else if (PH == PH_DNS) {
        const int sidx = C.c + i * C.G; if (sidx >= 128) return false; const int t = sidx >> 4, ks = sidx & 15; u.pm = 256 + (t >> 2); u.pn = t & 3;
        u.A = ws + WS_HID + (size_t)u.pm * 256 * 8192 + ks * 512; u.B = wl + WO_DN + (size_t)u.pn * 256 * 8192 + ks * 512; u.lda2 = 8192; u.ldb2 = 8192; u.nt = 4; u.kind = K_PART; u.aux = ks; return true;
    } else if (PH == PH_UP) {
        const int L = i * C.G + C.c; if (L >= NRT * 16) return false; tile_map(L, NRT, 16, u.pm, u.pn);
        u.A = ws + WS_XB + (size_t)u.pm * 256 * 2048; u.B = wl + WO_UP + (size_t)u.pn * 256 * 2048; u.lda2 = 2048; u.ldb2 = 2048; u.nt = 16; u.kind = K_UP; u.aux = 0; return true;
    } else {
        const int L = i * C.G + C.c; if (L >= 256 * 4) return false; tile_map(L, 256, 4, u.pm, u.pn);
        u.A = ws + WS_HID + (size_t)u.pm * 256 * 8192; u.B = wl + WO_DN + (size_t)u.pn * 256 * 8192; u.lda2 = 8192; u.ldb2 = 8192; u.nt = 64; u.kind = K_RES; u.aux = 0; return true;
    }
}

DI void gemm_epilogue(const Ctx& C, int layer, const f32x4 (&acc)[2][2][4][2], const UD& u, int wr, int wc, int fr, int fq, int tid, LAS unsigned char* lds) {
    unsigned char* ws = C.ws;
    const int row0 = u.pm * BM + wr * 64 + fr, col0 = u.pn * BM + wc * 32 + 8 * fq;
    if (u.kind == K_H) {
        bf16_t* H = (bf16_t*)(ws + WS_H);
#pragma unroll
        for (int ai = 0; ai < 2; ++ai)
#pragma unroll
            for (int m = 0; m < 4; ++m) { bf16_t* rowp = H + (size_t)(row0 + ai * HALF + m * 16) * HLD + col0;
#pragma unroll
                for (int bj = 0; bj < 2; ++bj) { const f32x4 v0 = acc[ai][bj][m][0], v1 = acc[ai][bj][m][1];
                    u32x4 w; w.x = pk(v0[0], v0[1]); w.y = pk(v0[2], v0[3]); w.z = pk(v1[0], v1[1]); w.w = pk(v1[2], v1[3]);
                    *(u32x4*)(rowp + bj * HALF) = w; } }
    } else if (u.kind == K_MKV) {
        bf16_t* MK = (bf16_t*)(ws + WS_MKV + (size_t)layer * MKV_L);
#pragma unroll
        for (int ai = 0; ai < 2; ++ai)
#pragma unroll
            for (int m = 0; m < 4; ++m) { const int r = row0 + ai * HALF + m * 16;
#pragma unroll
                for (int bj = 0; bj < 2; ++bj) { const f32x4 v0 = acc[ai][bj][m][0], v1 = acc[ai][bj][m][1]; const int c = col0 + bj * HALF;
                    u32x4 w; w.x = pk(v0[0], v0[1]); w.y = pk(v0[2], v0[3]); w.z = pk(v1[0], v1[1]); w.w = pk(v1[2], v1[3]);
                    *(u32x4*)(MK + (size_t)r * 1024 + c) = w;
                    float* o = C.out + (c < 512 ? O_PMK : O_PMV) + ((size_t)layer * 4096 + r) * 512 + (c & 511);
                    *(f32x4*)o = v0; *(f32x4*)(o + 4) = v1; } }
    } else if (u.kind == K_GATE) {
        unsigned char* gs = ws + WS_GS + (size_t)C.c * 131072;
#pragma unroll
        for (int ai = 0; ai < 2; ++ai)
#pragma unroll
            for (int m = 0; m < 4; ++m)
#pragma unroll
                for (int bj = 0; bj < 2; ++bj) { const f32x4 v0 = acc[ai][bj][m][0], v1 = acc[ai][bj][m][1]; const int idx = (ai * 4 + m) * 2 + bj;
                    u32x4 w; w.x = pk(sigmoidf_(v0[0]), sigmoidf_(v0[1])); w.y = pk(sigmoidf_(v0[2]), sigmoidf_(v0[3])); w.z = pk(sigmoidf_(v1[0]), sigmoidf_(v1[1])); w.w = pk(sigmoidf_(v1[2]), sigmoidf_(v1[3]));
                    unsigned off = (unsigned)(idx * NTHR + tid) * 16u; asm volatile("" : "+v"(off) :: "memory");
                    *(u32x4*)(gs + off) = w; }
    } else if (u.kind == K_BR) {
        unsigned char* gs = ws + WS_GS + (size_t)C.c * 131072;
        bf16_t* MG = (bf16_t*)(ws + WS_MERGED); const int b = u.aux & 15, mode = u.aux >> 4;
        const bf16_t* GT = (const bf16_t*)C.out + (size_t)b * MT * 1024;
#pragma unroll
        for (int ai = 0; ai < 2; ++ai) {
            unsigned off[8]; u32x4 g[8], p[8];
#pragma unroll
            for (int q = 0; q < 8; ++q) { const int m = q >> 1, bj = q & 1; const int idx = (ai * 4 + m) * 2 + bj; off[q] = (unsigned)(idx * NTHR + tid) * 16u; }
            asm volatile("" : "+v"(off[0]), "+v"(off[1]), "+v"(off[2]), "+v"(off[3]), "+v"(off[4]), "+v"(off[5]), "+v"(off[6]), "+v"(off[7]) :: "memory");
#pragma unroll
            for (int q = 0; q < 8; ++q) { const int m = q >> 1, bj = q & 1; const size_t ro = (size_t)(row0 + ai * HALF + m * 16) * 1024 + col0 + bj * HALF;
                if (b == 2) g[q] = *(const u32x4*)(gs + off[q]); else g[q] = *(const u32x4*)(GT + ro);
                if (mode > 0) p[q] = *(const u32x4*)(MG + ro); }
#pragma unroll
            for (int q = 0; q < 8; ++q) { const int m = q >> 1, bj = q & 1; const size_t ro = (size_t)(row0 + ai * HALF + m * 16) * 1024 + col0 + bj * HALF;
                f32x4 v0 = acc[ai][bj][m][0], v1 = acc[ai][bj][m][1];
                v0[0] *= bflo(g[q].x); v0[1] *= bfhi(g[q].x); v0[2] *= bflo(g[q].y); v0[3] *= bfhi(g[q].y); v1[0] *= bflo(g[q].z); v1[1] *= bfhi(g[q].z); v1[2] *= bflo(g[q].w); v1[3] *= bfhi(g[q].w);
                if (mode > 0) { v0[0] += bflo(p[q].x); v0[1] += bfhi(p[q].x); v0[2] += bflo(p[q].y); v0[3] += bfhi(p[q].y); v1[0] += bflo(p[q].z); v1[1] += bfhi(p[q].z); v1[2] += bflo(p[q].w); v1[3] += bfhi(p[q].w); }
                u32x4 w; w.x = pk(v0[0], v0[1]); w.y = pk(v0[2], v0[3]); w.z = pk(v1[0], v1[1]); w.w = pk(v1[2], v1[3]);
                *(u32x4*)(MG + ro) = w; }
            asm volatile("" ::: "memory");
        }
    } else if (u.kind == K_BRP) {
        const int b = u.aux;
        const bf16_t* GT = b < 2 ? (const bf16_t*)C.out + (size_t)b * MT * 1024 : (const bf16_t*)(ws + WS_GT2S) - (size_t)NP * 1024;
        float* SPM = (float*)(ws + WS_SPM) + (size_t)b * 512 * 1024 - (size_t)NP * 1024;
#pragma unroll
        for (int ai = 0; ai < 2; ++ai)
#pragma unroll
            for (int bj = 0; bj < 2; ++bj) {
                u32x4 g[4];
#pragma unroll
                for (int m = 0; m < 4; ++m) g[m] = *(const u32x4*)(GT + (size_t)(row0 + ai * HALF + m * 16) * 1024 + col0 + bj * HALF);
#pragma unroll
                for (int m = 0; m < 4; ++m) { f32x4 v0 = acc[ai][bj][m][0], v1 = acc[ai][bj][m][1];
                    v0[0] *= bflo(g[m].x); v0[1] *= bfhi(g[m].x); v0[2] *= bflo(g[m].y); v0[3] *= bfhi(g[m].y); v1[0] *= bflo(g[m].z); v1[1] *= bfhi(g[m].z); v1[2] *= bflo(g[m].w); v1[3] *= bfhi(g[m].w);
                    float* o = SPM + (size_t)(row0 + ai * HALF + m * 16) * 1024 + col0 + bj * HALF;
                    *(f32x4*)o = v0; *(f32x4*)(o + 4) = v1; }
                asm volatile("" ::: "memory");
            }
    } else if (u.kind == K_GATE2) {
        bf16_t* GT = u.aux < 2 ? (bf16_t*)C.out + (size_t)u.aux * MT * 1024 : (bf16_t*)(ws + WS_GT2S) - (size_t)NP * 1024;
#pragma unroll
        for (int ai = 0; ai < 2; ++ai)
#pragma unroll
            for (int m = 0; m < 4; ++m) { bf16_t* rowp = GT + (size_t)(row0 + ai * HALF + m * 16) * 1024 + col0;
#pragma unroll
                for (int bj = 0; bj < 2; ++bj) { const f32x4 v0 = acc[ai][bj][m][0], v1 = acc[ai][bj][m][1];
                    u32x4 w; w.x = pk(sigmoidf_(v0[0]), sigmoidf_(v0[1])); w.y = pk(sigmoidf_(v0[2]), sigmoidf_(v0[3])); w.z = pk(sigmoidf_(v1[0]), sigmoidf_(v1[1])); w.w = pk(sigmoidf_(v1[2]), sigmoidf_(v1[3]));
                    *(u32x4*)(rowp + bj * HALF) = w; } }
    } else if (u.kind == K_RES) {
        const bf16_t* XB = (const bf16_t*)(ws + WS_XB); float* Y = C.out + O_Y;
        LAS float* stats = (LAS float*)(lds + LDS_STATS);
#pragma unroll
        for (int ai = 0; ai < 2; ++ai) {
            u32x4 xr[4][2];
#pragma unroll
            for (int m = 0; m < 4; ++m)
#pragma unroll
                for (int bj = 0; bj < 2; ++bj) xr[m][bj] = *(const u32x4*)(XB + (size_t)(row0 + ai * HALF + m * 16) * 1024 + col0 + bj * HALF);
#pragma unroll
            for (int m = 0; m < 4; ++m) { const size_t off = (size_t)(row0 + ai * HALF + m * 16) * 1024 + col0;
                float s1 = 0.f, s2 = 0.f;
#pragma unroll
                for (int bj = 0; bj < 2; ++bj) { f32x4 v0 = acc[ai][bj][m][0], v1 = acc[ai][bj][m][1];
                    const u32x4 x = xr[m][bj];
                    v0[0] += DN_ALPHA * bflo(x.x); v0[1] += DN_ALPHA * bfhi(x.x); v0[2] += DN_ALPHA * bflo(x.y); v0[3] += DN_ALPHA * bfhi(x.y);
                    v1[0] += DN_ALPHA * bflo(x.z); v1[1] += DN_ALPHA * bfhi(x.z); v1[2] += DN_ALPHA * bflo(x.w); v1[3] += DN_ALPHA * bfhi(x.w);
                    s1 += (v0[0] + v0[1]) + (v0[2] + v0[3]) + (v1[0] + v1[1]) + (v1[2] + v1[3]);
                    s2 += (v0[0] * v0[0] + v0[1] * v0[1]) + (v0[2] * v0[2] + v0[3] * v0[3]) + (v1[0] * v1[0] + v1[1] * v1[1]) + (v1[2] * v1[2] + v1[3] * v1[3]);
                    if (u.aux) { *(f32x4*)(Y + off + bj * HALF) = v0; *(f32x4*)(Y + off + bj * HALF + 4) = v1; }
                    else { u32x4 w; w.x = pk(v0[0], v0[1]); w.y = pk(v0[2], v0[3]); w.z = pk(v1[0], v1[1]); w.w = pk(v1[2], v1[3]);
                        *(u32x4*)((bf16_t*)(Y + (size_t)(row0 + ai * HALF + m * 16) * 1024) + col0 + bj * HALF) = w; } }
                s1 += __shfl_xor(s1, 16); s1 += __shfl_xor(s1, 32); s2 += __shfl_xor(s2, 16); s2 += __shfl_xor(s2, 32);
                if (fq == 0 && u.aux) { const int rl = ai * HALF + wr * 64 + m * 16 + fr;
                    __hip_atomic_fetch_add(stats + 2 * rl, s1, __ATOMIC_RELAXED, __HIP_MEMORY_SCOPE_WORKGROUP);
                    __hip_atomic_fetch_add(stats + 2 * rl + 1, s2, __ATOMIC_RELAXED, __HIP_MEMORY_SCOPE_WORKGROUP); } }
            asm volatile("" ::: "memory");
        }
    } else if (u.kind == K_PART) {
        float* SP = (float*)(ws + WS_SP) + (size_t)u.aux * 512 * 1024;
#pragma unroll
        for (int ai = 0; ai < 2; ++ai)
#pragma unroll
            for (int m = 0; m < 4; ++m) { const size_t off = (size_t)(row0 + ai * HALF + m * 16 - NP) * 1024 + col0;
#pragma unroll
                for (int bj = 0; bj < 2; ++bj) { *(f32x4*)(SP + off + bj * HALF) = acc[ai][bj][m][0]; *(f32x4*)(SP + off + bj * HALF + 4) = acc[ai][bj][m][1]; } }
    } else {
        bf16_t* HID = (bf16_t*)(ws + WS_HID);
#pragma unroll
        for (int ai = 0; ai < 2; ++ai)
#pragma unroll
            for (int m = 0; m < 4; ++m) { bf16_t* rowp = HID + (size_t)(row0 + ai * HALF + m * 16) * DFF + col0;
#pragma unroll
                for (int bj = 0; bj < 2; ++bj) { f32x4 v0 = acc[ai][bj][m][0], v1 = acc[ai][bj][m][1];
#pragma unroll
                    for (int j = 0; j < 4; ++j) { const float a = fmaxf(v0[j], 0.f), b = fmaxf(v1[j], 0.f); v0[j] = a * a; v1[j] = b * b; }
                    u32x4 w; w.x = pk(v0[0], v0[1]); w.y = pk(v0[2], v0[3]); w.z = pk(v1[0], v1[1]); w.w = pk(v1[2], v1[3]);
                    *(u32x4*)(rowp + bj * HALF) = w; } }
    }
}

template <int PH>
DI void gemm_phase(LAS unsigned char* lds, const Ctx& C, int layer) {
    int tid_ = threadIdx.x; asm volatile("" : "+v"(tid_));
    const int tid = tid_, wid = __builtin_amdgcn_readfirstlane(tid >> 6), lane = tid & 63, wr = wid >> 2, wc = wid & 3, fr = lane & 15, fq = lane >> 4;
    int R0, C0; stage_rc(tid * 16, R0, C0);
    const int Rb0 = (R0 & ~31) + perm32(R0 & 31);
    const size_t kstep = (size_t)(BK * 2);
    const unsigned ldsw = (unsigned)wid * 1024u;
    const int aoff = lds_byte(wr * 64 + fr, fq * 8), boff = lds_byte(wc * 32 + fr, fq * 8);
#define G_SA(b, h) (((b) * 2 + (h)) * HTB)
#define G_SB(b, h) ((4 + (b) * 2 + (h)) * HTB)
#define G_STAGE(bufoff, gbase, v0, h64) do { \
        __builtin_amdgcn_global_load_lds((const unsigned*)((const char*)(gbase) + (v0)), (LAS unsigned*)(lds + (bufoff) + ldsw), 16, 0, 0); \
        __builtin_amdgcn_global_load_lds((const unsigned*)((const char*)(gbase) + (h64) + (v0)), (LAS unsigned*)(lds + (bufoff) + ldsw + 8192), 16, 0, 0); } while (0)
#define G_LDA(dst, b, h) do { _Pragma("unroll") for (int m = 0; m < 4; ++m) _Pragma("unroll") for (int k = 0; k < 2; ++k) dst[m][k] = *(const LAS bf16x8*)(lds + G_SA(b, h) + aoff + m * 2048 + k * 1024); } while (0)
#define G_LDB(dst, b, h) do { _Pragma("unroll") for (int n = 0; n < 2; ++n) _Pragma("unroll") for (int k = 0; k < 2; ++k) dst[n][k] = *(const LAS bf16x8*)(lds + G_SB(b, h) + boff + n * 2048 + k * 1024); } while (0)
#define G_MMA(ai, bj, At, Bt) do { __builtin_amdgcn_s_setprio(1); _Pragma("unroll") for (int m = 0; m < 4; ++m) _Pragma("unroll") for (int n = 0; n < 2; ++n) _Pragma("unroll") for (int k = 0; k < 2; ++k) \
        acc[ai][bj][m][n] = __builtin_amdgcn_mfma_f32_16x16x32_bf16(Bt[n][k], At[m][k], acc[ai][bj][m][n], 0, 0, 0); __builtin_amdgcn_s_setprio(0); } while (0)
#define G_WAIT_V(n) asm volatile("s_waitcnt vmcnt(" #n ")" ::: "memory")
#define G_WAIT_L(n) asm volatile("s_waitcnt lgkmcnt(" #n ")" ::: "memory")
#define G_BAR __builtin_amdgcn_s_barrier()
#define G_SCHED __builtin_amdgcn_sched_barrier(0)
    UD cur, nxt; int ui = 0;
    if (!get_unit<PH>(C, layer, 0, cur)) return;
    f32x4 acc[2][2][4][2];
#pragma unroll
    for (int a = 0; a < 2; ++a)
#pragma unroll
        for (int b = 0; b < 2; ++b)
#pragma unroll
            for (int m = 0; m < 4; ++m)
#pragma unroll
                for (int n = 0; n < 2; ++n) acc[a][b][m][n] = (f32x4){0.f, 0.f, 0.f, 0.f};
    bf16x8 At[4][2], B0[2][2], B1[2][2];
    const char* cA = cur.A; const char* cB = cur.B;
    unsigned cvA0 = (unsigned)R0 * cur.lda2 + C0 * 2, cvB0 = (unsigned)Rb0 * cur.ldb2 + C0 * 2;
    size_t chA = (size_t)HALF * cur.lda2, chB = (size_t)HALF * cur.ldb2;
    G_STAGE(G_SB(0, 0), cB, cvB0, chB / 2); G_STAGE(G_SA(0, 0), cA, cvA0, chA / 2); G_STAGE(G_SB(0, 1), cB + chB, cvB0, chB / 2); G_STAGE(G_SA(0, 1), cA + chA, cvA0, chA / 2);
    if (wr == 1) G_BAR;
    G_WAIT_V(4); G_BAR;
    G_STAGE(G_SB(1, 0), cB + kstep, cvB0, chB / 2); G_STAGE(G_SA(1, 0), cA + kstep, cvA0, chA / 2); G_STAGE(G_SB(1, 1), cB + chB + kstep, cvB0, chB / 2);
    G_WAIT_V(6); G_BAR;
    for (;;) {
        const bool has_next = get_unit<PH>(C, layer, ui + 1, nxt);
        if (!has_next) nxt = cur;
        const char* nA = nxt.A; const char* nB = nxt.B;
        const unsigned nvA0 = (unsigned)R0 * nxt.lda2 + C0 * 2, nvB0 = (unsigned)Rb0 * nxt.ldb2 + C0 * 2;
        const size_t nhA = (size_t)HALF * nxt.lda2, nhB = (size_t)HALF * nxt.ldb2;
        const int nt = cur.nt;
        for (int t = 0; t < nt; t += 2) {
            const bool last = (t == nt - 2);
            const char* a1 = cA + (size_t)(t + 1) * kstep;
            const char* a2 = last ? nA : cA + (size_t)(t + 2) * kstep; const char* b2 = last ? nB : cB + (size_t)(t + 2) * kstep;
            const char* a3 = a2 + kstep; const char* b3 = b2 + kstep;
            const unsigned sA0 = last ? nvA0 : cvA0, sB0 = last ? nvB0 : cvB0;
            const size_t shA = last ? nhA : chA, shB = last ? nhB : chB;
            G_LDB(B0, 0, 0); G_SCHED; G_LDA(At, 0, 0); G_STAGE(G_SA(1, 1), a1 + chA, cvA0, chA / 2);
            G_WAIT_L(8); G_BAR; G_WAIT_L(0); G_MMA(0, 0, At, B0); G_BAR; G_SCHED;
            G_LDB(B1, 0, 1); G_STAGE(G_SB(0, 0), b2, sB0, shB / 2);
            G_BAR; G_WAIT_L(0); G_MMA(0, 1, At, B1); G_BAR;
            G_LDA(At, 0, 1); G_STAGE(G_SA(0, 0), a2, sA0, shA / 2);
            G_BAR; G_WAIT_L(0); G_MMA(1, 0, At, B0); G_BAR; G_SCHED;
            G_STAGE(G_SB(0, 1), b2 + shB, sB0, shB / 2);
            G_WAIT_V(6); G_BAR; G_MMA(1, 1, At, B1); G_BAR;
            G_LDB(B0, 1, 0); G_SCHED; G_LDA(At, 1, 0); G_STAGE(G_SA(0, 1), a2 + shA, sA0, shA / 2);
            G_WAIT_L(8); G_BAR; G_WAIT_L(0); G_MMA(0, 0, At, B0); G_BAR; G_SCHED;
            G_LDB(B1, 1, 1); G_STAGE(G_SB(1, 0), b3, sB0, shB / 2);
            G_BAR; G_WAIT_L(0); G_MMA(0, 1, At, B1); G_BAR;
            G_LDA(At, 1, 1); G_STAGE(G_SA(1, 0), a3, sA0, shA / 2);
            G_BAR; G_WAIT_L(0); G_MMA(1, 0, At, B0); G_BAR; G_SCHED;
            G_STAGE(G_SB(1, 1), b3 + shB, sB0, shB / 2);
            G_WAIT_V(6); G_BAR; G_MMA(1, 1, At, B1); G_BAR;
        }
        gemm_epilogue(C, layer, acc, cur, wr, wc, fr, fq, tid, lds);
        if (!has_next) break;
#pragma unroll
        for (int a = 0; a < 2; ++a)
#pragma unroll
            for (int b = 0; b < 2; ++b)
#pragma unroll
                for (int m = 0; m < 4; ++m)
#pragma unroll
                    for (int n = 0; n < 2; ++n) acc[a][b][m][n] = (f32x4){0.f, 0.f, 0.f, 0.f};
        cur = nxt; cA = nA; cB = nB; cvA0 = nvA0; cvB0 = nvB0; chA = nhA; chB = nhB; ++ui;
    }
    G_WAIT_V(0);
    if (wr == 0) G_BAR;
    G_BAR;
#undef G_SA
#undef G_SB
#undef G_STAGE
#undef G_LDA
#undef G_LDB
#undef G_MMA
#undef G_WAIT_V
#undef G_WAIT_L
#undef G_BAR
#undef G_SCHED
}

DI void transpose_item(const float* W, int ldw, int srccol, int nvalid, bf16_t* WT, int K, int dstrow, int k0, LAS float* scr, int lane) {
    const int n = lane & 31;
#pragma unroll 16
    for (int i = 0; i < 32; ++i) { const int kk = 2 * i + (lane >> 5); scr[kk * 33 + n] = (n < nvalid) ? W[(size_t)(k0 + kk) * ldw + srccol + n] : 0.f; }
    asm volatile("s_waitcnt lgkmcnt(0)" ::: "memory");
    const int c = lane & 7;
#pragma unroll
    for (int j = 0; j < 4; ++j) { const int nn = (lane >> 3) + 8 * j; const LAS float* s = scr + (8 * c) * 33 + nn;
        u32x4 o; o.x = pk(s[0 * 33], s[1 * 33]); o.y = pk(s[2 * 33], s[3 * 33]); o.z = pk(s[4 * 33], s[5 * 33]); o.w = pk(s[6 * 33], s[7 * 33]);
        *(u32x4*)(WT + (size_t)(dstrow + nn) * K + k0 + 8 * c) = o; }
    asm volatile("s_waitcnt lgkmcnt(0)" ::: "memory");
}

DI void cvt8(const float* src, bf16_t* dst) {
    const f32x4 a = *(const f32x4*)src, b = *(const f32x4*)(src + 4);
    u32x4 w; w.x = pk(a[0], a[1]); w.y = pk(a[2], a[3]); w.z = pk(b[0], b[1]); w.w = pk(b[2], b[3]);
    *(u32x4*)dst = w;
}

DI void p0_convert(LAS unsigned char* lds, const Ctx& C) {
    int tid_ = threadIdx.x; asm volatile("" : "+v"(tid_));
    const int tid = tid_, lane = tid & 63, wid = tid >> 6;
    LAS float* scr = (LAS float*)(lds + wid * 16384);
    const int gw = C.c * 8 + wid, NGW = C.G * 8;
    constexpr int PER_L = 1792 + 1536 + 768 + 512 + 2048 + 2048 + 512;
    for (int it = gw; it < 2 * PER_L; it += NGW) {
        const int l = it / PER_L; int r = it % PER_L;
        unsigned char* wl = C.ws + WS_W + (size_t)l * WL_BYTES;
        if (r < 1792) { const int nb = r >> 4, kb = r & 15, d0 = nb * 32; int src = 0, nv = 32;
            if (d0 < 1536) src = d0; else if (d0 < 3328) src = d0 + 8; else if (d0 == 3328) { src = 1536; nv = 8; } else nv = 0;
            transpose_item(C.w_in + (size_t)l * DM * DIN, DIN, src, nv, (bf16_t*)(wl + WO_IN), 1024, d0, kb * 64, scr, lane); continue; }
        r -= 1792;
        if (r < 1536) { const int nb = r >> 4, kb = r & 15;
            transpose_item(C.w_in + (size_t)l * DM * DIN, DIN, 3336 + nb * 32, 32, (bf16_t*)(wl + WO_G), 1024, nb * 32, kb * 64, scr, lane); continue; }
        r -= 1536;
        if (r < 768) { const int b = r >> 8, rr = r & 255, nb = rr >> 3, kb = rr & 7;
            transpose_item(C.w_br + (size_t)(l * 3 + b) * 512 * 1024, 1024, nb * 32, 32, (bf16_t*)(wl + WO_BR) + (size_t)b * 1024 * 512, 512, nb * 32, kb * 64, scr, lane); continue; }
        r -= 768;
        if (r < 512) { const int nb = r >> 4, kb = r & 15;
            transpose_item(C.w_o + (size_t)l * 1024 * 1024, 1024, nb * 32, 32, (bf16_t*)(wl + WO_O), 1024, nb * 32, kb * 64, scr, lane); continue; }
        r -= 512;
        if (r < 2048) { const int nb = r >> 4, kb = r & 15;
            transpose_item(C.w_up + (size_t)l * 1024 * 4096, 4096, nb * 32, 32, (bf16_t*)(wl + WO_UP), 1024, nb * 32, kb * 64, scr, lane); continue; }
        r -= 2048;
        if (r < 2048) { const int nb = r >> 6, kb = r & 63;
            transpose_item(C.w_dn + (size_t)l * 4096 * 1024, 1024, nb * 32, 32, (bf16_t*)(wl + WO_DN), 4096, nb * 32, kb * 64, scr, lane); continue; }
        r -= 2048;
        { const int nb = r >> 4, kb = r & 15;
            transpose_item(C.w_mkv + (size_t)l * 1024 * 1024, 1024, nb * 32, 32, (bf16_t*)(wl + WO_MKV), 1024, nb * 32, kb * 64, scr, lane); }
    }
    const size_t gt = (size_t)C.c * NTHR + tid, GT = (size_t)C.G * NTHR;
    bf16_t* XB = (bf16_t*)(C.ws + WS_XB);
    {
        const size_t NG = (size_t)MT * 128;
        for (size_t i = gt; i < NG; i += 4 * GT) {
            f32x4 a[4], b[4]; size_t e[4]; bool ok[4];
#pragma unroll
            for (int k = 0; k < 4; ++k) { const size_t ii = i + (size_t)k * GT; ok[k] = ii < NG; e[k] = (ok[k] ? ii : i) * 8;
                const float* sp = e[k] < (size_t)NP * 1024 ? C.xp + e[k] : C.xs + (e[k] - (size_t)NP * 1024);
                a[k] = *(const f32x4*)sp; b[k] = *(const f32x4*)(sp + 4); }
#pragma unroll
            for (int k = 0; k < 4; ++k) if (ok[k]) { u32x4 w; w.x = pk(a[k][0], a[k][1]); w.y = pk(a[k][2], a[k][3]); w.z = pk(b[k][0], b[k][1]); w.w = pk(b[k][2], b[k][3]); *(u32x4*)(XB + e[k]) = w; }
        }
    }
    bf16_t* MB = (bf16_t*)(C.ws + WS_MEMB);
    for (size_t i = gt; i < (size_t)4096 * 128; i += GT) cvt8(C.memp + i * 8, MB + i * 8);
    for (size_t i = gt; i < (size_t)2 * 8192 * 128; i += GT) { const int c8 = (int)(i & 127); const size_t rr = (i >> 7) & 8191, l = i >> 20; const int c = c8 * 8;
        const float* s = (c < 512 ? C.cmk : C.cmv) + ((l * 8192 + rr) * 512 + (c & 511));
        cvt8(s, (bf16_t*)(C.ws + WS_MKV + l * MKV_L) + (4096 + rr) * 1024 + c); }
    for (size_t i = gt; i < (size_t)2 * 4096 * 32; i += GT) { const int c8 = (int)(i & 31); const size_t rr = (i >> 5) & 4095, l = i >> 17; const int c = c8 * 8;
        const float* s = (c < 128 ? C.csk : C.csv) + ((l * 4096 + rr) * 128 + (c & 127));
        cvt8(s, (bf16_t*)(C.ws + WS_SWC + l * SWC_L) + rr * 256 + c); }
}

DI void ln_zero_stats(LAS unsigned char* lds) {
    int tid_ = threadIdx.x; asm volatile("" : "+v"(tid_));
    ((LAS float*)(lds + LDS_STATS))[tid_] = 0.f;
    __syncthreads();
}
DI void ln_panel_sweep(LAS unsigned char* lds, const Ctx& C, int panel, const float* gam, const float* bet, bool final_out) {
    int tid_ = threadIdx.x; asm volatile("" : "+v"(tid_));
    const int tid = tid_, lane = tid & 63, wid = tid >> 6;
    __syncthreads();
    const LAS float* stats = (const LAS float*)(lds + LDS_STATS);
    float* Y = C.out + O_Y; bf16_t* XB = (bf16_t*)(C.ws + WS_XB);
    f32x4 g4[4], b4[4];
#pragma unroll
    for (int j = 0; j < 4; ++j) { g4[j] = ((const f32x4*)gam)[lane + 64 * j]; b4[j] = ((const f32x4*)bet)[lane + 64 * j]; }
#pragma unroll 2
    for (int rr = wid; rr < 256; rr += 8) {
        const int row = panel * 256 + rr;
        const float mean = stats[2 * rr] * (1.f / 1024.f);
        const float var = fmaxf(stats[2 * rr + 1] * (1.f / 1024.f) - mean * mean, 0.f);
        const float rstd = rsqrtf(var + 1e-5f);
        f32x4* yr = (f32x4*)(Y + (size_t)row * 1024) + lane;
#pragma unroll
        for (int j = 0; j < 4; ++j) { const f32x4 o4 = (yr[64 * j] - mean) * rstd * g4[j] + b4[j];
            if (final_out) yr[64 * j] = o4;
            else { u32x2 w; w.x = pk(o4[0], o4[1]); w.y = pk(o4[2], o4[3]); *((u32x2*)(XB + (size_t)row * 1024) + lane + 64 * j) = w; } }
    }
    __syncthreads();
}
DI void ln_sample(const Ctx& C, int nsplit, const float* gam, const float* bet, bool final_out) {
    int tid_ = threadIdx.x; asm volatile("" : "+v"(tid_));
    const int tid = tid_, lane = tid & 63, wid = tid >> 6;
    float* Y = C.out + O_Y; bf16_t* XB = (bf16_t*)(C.ws + WS_XB); const float* SP = (const float*)(C.ws + WS_SP);
    for (int r = C.c * 8 + wid; r < NS; r += C.G * 8) {
        const int row = NP + r;
        f32x4 v[4]; float s = 0.f;
#pragma unroll
        for (int j = 0; j < 4; ++j) { const u32x2 x = *((const u32x2*)(XB + (size_t)row * 1024) + lane + 64 * j);
            v[j] = (f32x4){DN_ALPHA * bflo(x.x), DN_ALPHA * bfhi(x.x), DN_ALPHA * bflo(x.y), DN_ALPHA * bfhi(x.y)}; }
        for (int sp = 0; sp < nsplit; ++sp) { const f32x4* pr = (const f32x4*)(SP + ((size_t)sp * 512 + r) * 1024) + lane;
#pragma unroll
            for (int j = 0; j < 4; ++j) v[j] += pr[64 * j]; }
#pragma unroll
        for (int j = 0; j < 4; ++j) s += (v[j][0] + v[j][1]) + (v[j][2] + v[j][3]);
#pragma unroll
        for (int o = 1; o < 64; o <<= 1) s += __shfl_xor(s, o);
        const float mean = s * (1.f / 1024.f); float s2 = 0.f;
#pragma unroll
        for (int j = 0; j < 4; ++j) { v[j] = v[j] - mean; s2 += (v[j][0] * v[j][0] + v[j][1] * v[j][1]) + (v[j][2] * v[j][2] + v[j][3] * v[j][3]); }
#pragma unroll
        for (int o = 1; o < 64; o <<= 1) s2 += __shfl_xor(s2, o);
        const float rstd = rsqrtf(s2 * (1.f / 1024.f) + 1e-5f);
#pragma unroll
        for (int j = 0; j < 4; ++j) { const f32x4 g4 = ((const f32x4*)gam)[lane + 64 * j], b4 = ((const f32x4*)bet)[lane + 64 * j]; const f32x4 o4 = v[j] * rstd * g4 + b4;
            if (final_out) *((f32x4*)(Y + (size_t)row * 1024) + lane + 64 * j) = o4;
            else { u32x2 w; w.x = pk(o4[0], o4[1]); w.y = pk(o4[2], o4[3]); *((u32x2*)(XB + (size_t)row * 1024) + lane + 64 * j) = w; } }
    }
}

DI void ln_phase(const Ctx& C, const float* gam, const float* bet, bool final_out) {
    int tid_ = threadIdx.x; asm volatile("" : "+v"(tid_));
    const int tid = tid_, lane = tid & 63, wid = tid >> 6;
    float* Y = C.out + O_Y; bf16_t* XB = (bf16_t*)(C.ws + WS_XB);
    f32x4 g4[4], b4[4];
#pragma unroll
    for (int j = 0; j < 4; ++j) { g4[j] = ((const f32x4*)gam)[lane + 64 * j]; b4[j] = ((const f32x4*)bet)[lane + 64 * j]; }
    for (int row0 = (C.c * 8 + wid) * 2; row0 < NP; row0 += C.G * 16) {
        u32x2 raw[2][4];
#pragma unroll
        for (int rr = 0; rr < 2; ++rr)
#pragma unroll
            for (int j = 0; j < 4; ++j) raw[rr][j] = *((const u32x2*)(Y + (size_t)(row0 + rr) * 1024) + lane + 64 * j);
#pragma unroll
        for (int rr = 0; rr < 2; ++rr) {
            const int row = row0 + rr;
            f32x4 v[4]; float s = 0.f;
#pragma unroll
            for (int j = 0; j < 4; ++j) { v[j] = (f32x4){bflo(raw[rr][j].x), bfhi(raw[rr][j].x), bflo(raw[rr][j].y), bfhi(raw[rr][j].y)}; s += (v[j][0] + v[j][1]) + (v[j][2] + v[j][3]); }
#pragma unroll
            for (int o = 1; o < 64; o <<= 1) s += __shfl_xor(s, o);
            const float mean = s * (1.f / 1024.f); float s2 = 0.f;
#pragma unroll
            for (int j = 0; j < 4; ++j) { v[j] = v[j] - mean; s2 += (v[j][0] * v[j][0] + v[j][1] * v[j][1]) + (v[j][2] * v[j][2] + v[j][3] * v[j][3]); }
#pragma unroll
            for (int o = 1; o < 64; o <<= 1) s2 += __shfl_xor(s2, o);
            const float rstd = rsqrtf(s2 * (1.f / 1024.f) + 1e-5f);
#pragma unroll
            for (int j = 0; j < 4; ++j) { const f32x4 o4 = v[j] * rstd * g4[j] + b4[j];
                if (final_out) *((f32x4*)(Y + (size_t)row * 1024) + lane + 64 * j) = o4;
                else { u32x2 w; w.x = pk(o4[0], o4[1]); w.y = pk(o4[2], o4[3]); *((u32x2*)(XB + (size_t)row * 1024) + lane + 64 * j) = w; } }
        }
    }
}
DI void merge_fixup(const Ctx& C) {
    int tid_ = threadIdx.x; asm volatile("" : "+v"(tid_));
    const float* SPM = (const float*)(C.ws + WS_SPM); bf16_t* MG = (bf16_t*)(C.ws + WS_MERGED) + (size_t)NP * 1024;
    for (int i = C.c * NTHR + tid_; i < 512 * 128; i += C.G * NTHR) { const size_t e = (size_t)i * 8;
        f32x4 a = *(const f32x4*)(SPM + e), b = *(const f32x4*)(SPM + e + 4);
#pragma unroll
        for (int k = 1; k < 3; ++k) { a += *(const f32x4*)(SPM + (size_t)k * 512 * 1024 + e); b += *(const f32x4*)(SPM + (size_t)k * 512 * 1024 + e + 4); }
        u32x4 w; w.x = pk(a[0], a[1]); w.y = pk(a[2], a[3]); w.z = pk(b[0], b[1]); w.w = pk(b[2], b[3]);
        *(u32x4*)(MG + e) = w; }
}

DI void state_copies(const Ctx& C, int l) {
    const bf16_t* H = (const bf16_t*)(C.ws + WS_H);
    int tid_ = threadIdx.x; asm volatile("" : "+v"(tid_));
    const size_t gt = (size_t)C.c * NTHR + tid_, GT = (size_t)C.G * NTHR;
    for (size_t i = gt; i < (size_t)16 * 3 * 1536; i += GT) { const int c = (int)(i % 1536); const int j = (int)((i / 1536) % 3), b = (int)(i / 4608);
        C.out[O_PGC + (size_t)l * 73728 + i] = bf2f(H[(size_t)(b * 4096 + 4093 + j) * HLD + c]); }
    for (size_t i = gt; i < (size_t)32 * 3 * 1536; i += GT) { const int c = (int)(i % 1536); const int j = (int)((i / 1536) % 3), sb = (int)(i / 4608);
        C.out[O_SGC + (size_t)l * 147456 + i] = bf2f(H[(size_t)(NP + sb * 16 + 13 + j) * HLD + c]); }
    for (size_t i = gt; i < (size_t)16 * 128 * 128; i += GT) { const int c = (int)(i & 127), r = (int)((i >> 7) & 127), b = (int)(i >> 14);
        const bf16_t* hr = H + (size_t)(b * 4096 + 3968 + r) * HLD;
        C.out[O_PSK + (size_t)l * 262144 + i] = bf2f(hr[C_SK + c]); C.out[O_PSV + (size_t)l * 262144 + i] = bf2f(hr[C_SV + c]); }
    for (size_t i = gt; i < (size_t)32 * 128 * 128; i += GT) { const int c = (int)(i & 127), r = (int)((i >> 7) & 127), sb = (int)(i >> 14);
        float k, v;
        if (r < 112) { const size_t si = (((size_t)l * 32 + sb) * 128 + (r + 16)) * 128 + c; k = C.csk[si]; v = C.csv[si]; }
        else { const bf16_t* hr = H + (size_t)(NP + sb * 16 + (r - 112)) * HLD; k = bf2f(hr[C_SK + c]); v = bf2f(hr[C_SV + c]); }
        C.out[O_SSK + (size_t)l * 524288 + i] = k; C.out[O_SSV + (size_t)l * 524288 + i] = v; }
}

DI void conv_load(const bf16_t* H, int rowbase, int pos0, int tok, bool tv, int col, u32x4 (&ha)[4], u32x4 (&hb)[4]) {
#pragma unroll
    for (int w = 0; w < 4; ++w) {
        const int pos = pos0 + tok - 3 + w;
        ha[w] = (u32x4){0u, 0u, 0u, 0u}; hb[w] = (u32x4){0u, 0u, 0u, 0u};
        if (tv && pos >= 0) { const u32x4* p = (const u32x4*)(H + (size_t)(rowbase + pos) * HLD + col); ha[w] = p[0]; hb[w] = p[1]; }
    }
}
DI void conv_compute(const Ctx& C, int l, int pos0, int tok, bool tv, bool sample, int sb, int col, const LAS float* cwl, const u32x4 (&ha)[4], const u32x4 (&hb)[4], float (&o)[16]) {
#pragma unroll
    for (int i = 0; i < 16; ++i) o[i] = 0.f;
#pragma unroll
    for (int w = 0; w < 4; ++w) {
        const int pos = pos0 + tok - 3 + w;
        float xv[16];
        const u32x4 a = ha[w], b = hb[w];
        xv[0] = bflo(a.x); xv[1] = bfhi(a.x); xv[2] = bflo(a.y); xv[3] = bfhi(a.y); xv[4] = bflo(a.z); xv[5] = bfhi(a.z); xv[6] = bflo(a.w); xv[7] = bfhi(a.w);
        xv[8] = bflo(b.x); xv[9] = bfhi(b.x); xv[10] = bflo(b.y); xv[11] = bfhi(b.y); xv[12] = bflo(b.z); xv[13] = bfhi(b.z); xv[14] = bflo(b.w); xv[15] = bfhi(b.w);
        if (tv && sample && pos < 0) {
            const f32x4* p = (const f32x4*)(C.st_conv + (((size_t)l * 32 + sb) * 3 + (3 + pos)) * 1536 + col);
#pragma unroll
            for (int q = 0; q < 4; ++q) { const f32x4 t = p[q]; xv[4 * q] = t[0]; xv[4 * q + 1] = t[1]; xv[4 * q + 2] = t[2]; xv[4 * q + 3] = t[3]; }
        }
#pragma unroll
        for (int q = 0; q < 4; ++q) { const f32x4 t = *(const LAS f32x4*)(cwl + w * 128 + 4 * q); o[4 * q] += xv[4 * q] * t[0]; o[4 * q + 1] += xv[4 * q + 1] * t[1]; o[4 * q + 2] += xv[4 * q + 2] * t[2]; o[4 * q + 3] += xv[4 * q + 3] * t[3]; }
    }
#pragma unroll
    for (int i = 0; i < 16; ++i) o[i] = tv ? o[i] * sigmoidf_(o[i]) : 0.f;
}

constexpr int PP_HB = 53248;
DI void gdn_pre_pair(LAS unsigned char* lds, const Ctx& C, int l, int pair) {
    int tid_ = threadIdx.x; asm volatile("" : "+v"(tid_));
    const int tid = tid_, lane = tid & 63, wid = tid >> 6, half = tid >> 8, ltid = tid & 255, lw = wid & 3;
    const int h = pair & 3, ci = (pair >> 2) * 2 + half, item = ci * 4 + h;
    int rowbase, pos0, nvalid, sb = 0; bool sample;
    if (ci < 1024) { rowbase = (ci >> 6) * 4096; pos0 = (ci & 63) * 64; nvalid = 64; sample = false; }
    else { sb = ci - 1024; rowbase = NP + sb * 16; pos0 = 0; nvalid = 16; sample = true; }
    const bf16_t* H = (const bf16_t*)(C.ws + WS_H);
    LAS unsigned char* hb = lds + half * PP_HB;
    LAS bf16_t* kB = (LAS bf16_t*)(hb); LAS bf16_t* qB = (LAS bf16_t*)(hb + 17408); LAS float* Lm = (LAS float*)(hb + 17408);
    LAS bf16_t* RU = (LAS bf16_t*)(hb + 34816); LAS float* gs = (LAS float*)(hb + 52224);
    LAS float* cwL = (LAS float*)(lds + 2 * PP_HB);
    unsigned char* gp = C.ws + WS_G + (size_t)item * GP_ITEM;
    bf16_t* oNW = (bf16_t*)gp; bf16_t* oQE = (bf16_t*)(gp + 16384); bf16_t* oKDT = (bf16_t*)(gp + 32768); bf16_t* oUT = (bf16_t*)(gp + 49152); bf16_t* oQK = (bf16_t*)(gp + 65536);
    const int tok = ltid >> 2, grp = ltid & 3, c0 = grp * 32;
    const bool tv = tok < nvalid;
    u32x4 hA[3][2][4], hB[3][2][4];
    conv_load(H, rowbase, pos0, tok, tv, 0 * 512 + h * 128 + c0, hA[0][0], hB[0][0]); conv_load(H, rowbase, pos0, tok, tv, 0 * 512 + h * 128 + c0 + 16, hA[0][1], hB[0][1]);
    if (ltid < 64) {
        float g = 0.f, be = 0.f;
        if (ltid < nvalid) {
            const bf16_t* hr = H + (size_t)(rowbase + pos0 + ltid) * HLD;
            const float a = bf2f(hr[C_A + h]), bb = bf2f(hr[C_B + h]);
            const float x = a + C.dt_bias[l * 4 + h];
            const float sp = fmaxf(x, 0.f) + __logf(1.f + __expf(-fabsf(x)));
            g = -__expf(C.a_log[l * 4 + h]) * sp;
            be = sigmoidf_(bb);
        }
        float c = g;
#pragma unroll
        for (int o = 1; o < 64; o <<= 1) { const float t = __shfl_up(c, o); if (lane >= o) c += t; }
        gs[ltid] = be * __expf(c); gs[64 + ltid] = be; gs[128 + ltid] = c; gs[192 + ltid] = 1.f;
    } else {
        const int idx = half * 192 + (ltid - 64), seg = idx >> 7, ch = idx & 127;
#pragma unroll
        for (int w = 0; w < 4; ++w) cwL[(seg * 4 + w) * 128 + ch] = C.conv_w[((size_t)l * 4 + w) * 1536 + seg * 512 + h * 128 + ch];
    }
    lds_barrier();
    const float gc = gs[128 + tok], glast = gs[128 + 63];
    const float beta = gs[64 + tok], egc = __expf(gc);
#pragma unroll
    for (int seg = 0; seg < 3; ++seg) {
        float va[16], vb[16];
        if (seg < 2) { conv_load(H, rowbase, pos0, tok, tv, (seg + 1) * 512 + h * 128 + c0, hA[seg + 1 < 3 ? seg + 1 : 2][0], hB[seg + 1 < 3 ? seg + 1 : 2][0]);
                       conv_load(H, rowbase, pos0, tok, tv, (seg + 1) * 512 + h * 128 + c0 + 16, hA[seg + 1 < 3 ? seg + 1 : 2][1], hB[seg + 1 < 3 ? seg + 1 : 2][1]); }
        conv_compute(C, l, pos0, tok, tv, sample, sb, seg * 512 + h * 128 + c0, cwL + seg * 512 + c0, hA[seg][0], hB[seg][0], va);
        conv_compute(C, l, pos0, tok, tv, sample, sb, seg * 512 + h * 128 + c0 + 16, cwL + seg * 512 + c0 + 16, hA[seg][1], hB[seg][1], vb);
        float sc = beta;
        if (seg < 2) {
            float ss = 0.f;
#pragma unroll
            for (int i = 0; i < 16; ++i) ss += va[i] * va[i] + vb[i] * vb[i];
            ss += __shfl_xor(ss, 1); ss += __shfl_xor(ss, 2);
            sc = rsqrtf(ss + 1e-6f) * (seg == 0 ? 0.08838834764831845f : 1.f);
        }
#pragma unroll
        for (int i = 0; i < 16; ++i) { va[i] *= sc; vb[i] *= sc; }
        LAS bf16_t* dst = (seg == 0 ? qB : (seg == 1 ? kB : RU)) + tok * 136 + c0;
        u32x4 w0, w1, w2, w3;
        w0.x = pk(va[0], va[1]); w0.y = pk(va[2], va[3]); w0.z = pk(va[4], va[5]); w0.w = pk(va[6], va[7]);
        w1.x = pk(va[8], va[9]); w1.y = pk(va[10], va[11]); w1.z = pk(va[12], va[13]); w1.w = pk(va[14], va[15]);
        w2.x = pk(vb[0], vb[1]); w2.y = pk(vb[2], vb[3]); w2.z = pk(vb[4], vb[5]); w2.w = pk(vb[6], vb[7]);
        w3.x = pk(vb[8], vb[9]); w3.y = pk(vb[10], vb[11]); w3.z = pk(vb[12], vb[13]); w3.w = pk(vb[14], vb[15]);
        *(LAS u32x4*)(dst) = w0; *(LAS u32x4*)(dst + 8) = w1; *(LAS u32x4*)(dst + 16) = w2; *(LAS u32x4*)(dst + 24) = w3;
        if (seg == 0) {
            u32x4 e0, e1, e2, e3;
            e0.x = pk(va[0] * egc, va[1] * egc); e0.y = pk(va[2] * egc, va[3] * egc); e0.z = pk(va[4] * egc, va[5] * egc); e0.w = pk(va[6] * egc, va[7] * egc);
            e1.x = pk(va[8] * egc, va[9] * egc); e1.y = pk(va[10] * egc, va[11] * egc); e1.z = pk(va[12] * egc, va[13] * egc); e1.w = pk(va[14] * egc, va[15] * egc);
            e2.x = pk(vb[0] * egc, vb[1] * egc); e2.y = pk(vb[2] * egc, vb[3] * egc); e2.z = pk(vb[4] * egc, vb[5] * egc); e2.w = pk(vb[6] * egc, vb[7] * egc);
            e3.x = pk(vb[8] * egc, vb[9] * egc); e3.y = pk(vb[10] * egc, vb[11] * egc); e3.z = pk(vb[12] * egc, vb[13] * egc); e3.w = pk(vb[14] * egc, vb[15] * egc);
            bf16_t* qe = oQE + tok * 128 + c0;
            *(u32x4*)(qe) = e0; *(u32x4*)(qe + 8) = e1; *(u32x4*)(qe + 16) = e2; *(u32x4*)(qe + 24) = e3;
        }
        asm volatile("" ::: "memory");
    }
    lds_barrier();
    const int fr = lane & 15, fq = lane >> 4;
    f32x4 ga[2][4];
#pragma unroll
    for (int tk = 0; tk < 2; ++tk) {
        const LAS bf16_t* Xm = tk ? qB : kB;
        bf16x8 xf[4];
#pragma unroll
        for (int ks = 0; ks < 4; ++ks) xf[ks] = *(const LAS bf16x8*)(Xm + (16 * lw + fr) * 136 + 32 * ks + 8 * fq);
#pragma unroll
        for (int nt = 0; nt < 4; ++nt) {
            f32x4 a = {0.f, 0.f, 0.f, 0.f};
#pragma unroll
            for (int ks = 0; ks < 4; ++ks) { const bf16x8 yf = *(const LAS bf16x8*)(kB + (16 * nt + fr) * 136 + 32 * ks + 8 * fq); a = mfma16(xf[ks], yf, a); }
            ga[tk][nt] = a;
        }
    }
    lds_barrier();
#pragma unroll
    for (int nt = 0; nt < 4; ++nt) {
        const int jj = 16 * nt + fr; const float gcj = gs[128 + jj];
#pragma unroll
        for (int j = 0; j < 4; ++j) { const int i = 16 * lw + 4 * fq + j; const float gci = gs[128 + i];
            const float dec = __expf(fminf(gci - gcj, 0.f));
            Lm[i * 68 + jj] = (jj < i) ? gs[64 + i] * ga[0][nt][j] * dec : 0.f;
            oQK[i * 64 + jj] = f2bf((jj <= i) ? ga[1][nt][j] * dec : 0.f); }
    }
    lds_barrier();
    if (lw < 2) {
        const int col = 64 * lw + lane;
        f32x2 x[64];
#pragma unroll
        for (int i = 0; i < 64; i += 2) {
            f32x2 a0 = {bf2f(RU[i * 136 + col]), bf2f(kB[i * 136 + col]) * gs[i]}, a1 = {0.f, 0.f};
            f32x2 b0 = {bf2f(RU[(i + 1) * 136 + col]), bf2f(kB[(i + 1) * 136 + col]) * gs[i + 1]}, b1 = {0.f, 0.f};
#pragma unroll
            for (int jb = 0; jb < (i + 3) / 4; ++jb) {
                const f32x4 la = *(const LAS f32x4*)(Lm + i * 68 + 4 * jb), lb = *(const LAS f32x4*)(Lm + (i + 1) * 68 + 4 * jb);
                if (4 * jb + 0 < i) { a0 -= la[0] * x[4 * jb + 0]; b0 -= lb[0] * x[4 * jb + 0]; }
                if (4 * jb + 1 < i) { a1 -= la[1] * x[4 * jb + 1]; b1 -= lb[1] * x[4 * jb + 1]; }
                if (4 * jb + 2 < i) { a0 -= la[2] * x[4 * jb + 2]; b0 -= lb[2] * x[4 * jb + 2]; }
                if (4 * jb + 3 < i) { a1 -= la[3] * x[4 * jb + 3]; b1 -= lb[3] * x[4 * jb + 3]; }
            }
            x[i] = a0 + a1;
            x[i + 1] = (b0 + b1) - Lm[(i + 1) * 68 + i] * x[i];
        }
#pragma unroll
        for (int i8 = 0; i8 < 8; ++i8) { u32x4 w; w.x = pk(x[8 * i8].x, x[8 * i8 + 1].x); w.y = pk(x[8 * i8 + 2].x, x[8 * i8 + 3].x); w.z = pk(x[8 * i8 + 4].x, x[8 * i8 + 5].x); w.w = pk(x[8 * i8 + 6].x, x[8 * i8 + 7].x);
            *(u32x4*)(oUT + col * 64 + 8 * i8) = w; }
#pragma unroll
        for (int i = 0; i < 64; ++i) oNW[i * 128 + col] = f2bf(-x[i].y);
    } else {
        const int dk = ltid - 128;
#pragma unroll
        for (int g8 = 0; g8 < 8; ++g8) {
            float v[8];
#pragma unroll
            for (int e = 0; e < 8; ++e) { const int t = 8 * g8 + e; v[e] = bf2f(kB[t * 136 + dk]) * __expf(fminf(glast - gs[128 + t], 0.f)); }
            u32x4 w; w.x = pk(v[0], v[1]); w.y = pk(v[2], v[3]); w.z = pk(v[4], v[5]); w.w = pk(v[6], v[7]);
            *(u32x4*)(oKDT + dk * 64 + 8 * g8) = w;
        }
        if (dk == 0) ((float*)(C.ws + WS_EG))[item] = __expf(glast);
    }
    lds_barrier();
}

constexpr int SB_NW = 0, SB_QE = 17408, SB_QK = 34816, SB_KDT = 44032, SB_BYTES = 62464, SB_SSQ = 2 * SB_BYTES;
DI void scan_load(const unsigned char* gp, int tid, u32x4 (&st)[7]) {
    const u32x4* p = (const u32x4*)gp;
    st[0] = p[tid]; st[1] = p[tid + 512];
    st[2] = p[1024 + tid]; st[3] = p[1024 + tid + 512];
    st[4] = p[4096 + tid];
    st[5] = p[2048 + tid]; st[6] = p[2048 + tid + 512];
}
DI void scan_store(LAS unsigned char* buf, int tid, const u32x4 (&st)[7]) {
#pragma unroll
    for (int k = 0; k < 2; ++k) { const int q = tid + 512 * k;
        *(LAS u32x4*)(buf + SB_NW + (q >> 4) * 272 + (q & 15) * 16) = st[k];
        *(LAS u32x4*)(buf + SB_QE + (q >> 4) * 272 + (q & 15) * 16) = st[2 + k];
        *(LAS u32x4*)(buf + SB_KDT + (q >> 3) * 144 + (q & 7) * 16) = st[5 + k]; }
    *(LAS u32x4*)(buf + SB_QK + (tid >> 3) * 144 + (tid & 7) * 16) = st[4];
}
DI bf16x8 lds_a2(const LAS unsigned char* base, int rowbytes, int row, int k0, int fq) {
    const LAS unsigned char* p = base + row * rowbytes + (k0 + 4 * fq) * 2;
    const u32x2 lo = *(const LAS u32x2*)p, hi = *(const LAS u32x2*)(p + 32);
    return mk8(lo.x, lo.y, hi.x, hi.y);
}

DI void gdn_scan_item(LAS unsigned char* lds, const Ctx& C, int l, int sitem) {
    int tid_ = threadIdx.x; asm volatile("" : "+v"(tid_));
    const int tid = tid_, lane = tid & 63, wid = tid >> 6, fr = lane & 15, fq = lane >> 4;
    int ci0, nsteps, rowbase, h, bidx; bool sample;
    if (sitem < 64) { bidx = sitem >> 2; h = sitem & 3; ci0 = bidx * 64; nsteps = 64; rowbase = bidx * 4096; sample = false; }
    else { const int s2 = sitem - 64; bidx = s2 >> 2; h = s2 & 3; ci0 = 1024 + bidx; nsteps = 1; rowbase = NP + bidx * 16; sample = true; }
    const int nvalid = sample ? 16 : 64;
    const int dv = 16 * wid + fr;
    f32x4 S[8];
    if (sample) { const float* s0 = C.st_s + (((size_t)l * 32 + bidx) * 4 + h) * 16384;
#pragma unroll
        for (int m = 0; m < 8; ++m)
#pragma unroll
            for (int j = 0; j < 4; ++j) S[m][j] = s0[(16 * m + 4 * fq + j) * 128 + dv]; }
    else {
#pragma unroll
        for (int m = 0; m < 8; ++m) S[m] = (f32x4){0.f, 0.f, 0.f, 0.f}; }
    const unsigned char* gp0 = C.ws + WS_G;
    const float* EG = (const float*)(C.ws + WS_EG);
    bf16_t* H = (bf16_t*)(C.ws + WS_H);
    u32x4 st[7]; u32x2 ut[4];
    f32x4 nw4[4];
#pragma unroll
    for (int q = 0; q < 4; ++q) nw4[q] = *(const f32x4*)(C.gnw + l * 128 + (tid & 7) * 16 + 4 * q);
    float eg = EG[ci0 * 4 + h];
    {
        const unsigned char* gp = gp0 + (size_t)(ci0 * 4 + h) * GP_ITEM;
        scan_load(gp, tid, st);
#pragma unroll
        for (int m = 0; m < 4; ++m) ut[m] = *(const u32x2*)(gp + 49152 + (dv * 64 + 16 * m + 4 * fq) * 2);
        scan_store(lds, tid, st);
    }
    lds_barrier();
    for (int step = 0; step < nsteps; ++step) {
        const int item = (ci0 + step) * 4 + h;
        LAS unsigned char* buf = lds + (step & 1) * SB_BYTES;
        const bool has_next = step + 1 < nsteps;
        u32x2 utn[4];
        if (has_next) { const unsigned char* gp = gp0 + (size_t)(item + 4) * GP_ITEM; scan_load(gp, tid, st);
#pragma unroll
            for (int m = 0; m < 4; ++m) utn[m] = *(const u32x2*)(gp + 49152 + (dv * 64 + 16 * m + 4 * fq) * 2); }
        else {
#pragma unroll
            for (int m = 0; m < 4; ++m) utn[m] = (u32x2){0u, 0u}; }
        const int ztok = tid >> 3, zc0 = (tid & 7) * 16;
        bf16_t* zp = H + (size_t)(rowbase + step * 64 + ztok) * HLD + C_Z + h * 128 + zc0;
        u32x4 za = {0u, 0u, 0u, 0u}, zb = {0u, 0u, 0u, 0u};
        if (ztok < nvalid) { za = *(const u32x4*)zp; zb = *(const u32x4*)(zp + 8); }
        const float egn = has_next ? EG[item + 4] : 0.f;
        bf16x8 sbv[4];
#pragma unroll
        for (int ks = 0; ks < 4; ++ks) sbv[ks] = mk8(pk(S[2 * ks][0], S[2 * ks][1]), pk(S[2 * ks][2], S[2 * ks][3]), pk(S[2 * ks + 1][0], S[2 * ks + 1][1]), pk(S[2 * ks + 1][2], S[2 * ks + 1][3]));
        f32x4 vn[4], o[4];
#pragma unroll
        for (int m = 0; m < 4; ++m) {
            vn[m] = (f32x4){bflo(ut[m].x), bfhi(ut[m].x), bflo(ut[m].y), bfhi(ut[m].y)};
            o[m] = (f32x4){0.f, 0.f, 0.f, 0.f};
#pragma unroll
            for (int ks = 0; ks < 4; ++ks) {
                vn[m] = mfma16(lds_a2(buf + SB_NW, 272, 16 * m + fr, 32 * ks, fq), sbv[ks], vn[m]);
                o[m] = mfma16(lds_a2(buf + SB_QE, 272, 16 * m + fr, 32 * ks, fq), sbv[ks], o[m]);
            }
            asm volatile("" ::: "memory");
        }
        bf16x8 vb[2];
#pragma unroll
        for (int kt = 0; kt < 2; ++kt) vb[kt] = mk8(pk(vn[2 * kt][0], vn[2 * kt][1]), pk(vn[2 * kt][2], vn[2 * kt][3]), pk(vn[2 * kt + 1][0], vn[2 * kt + 1][1]), pk(vn[2 * kt + 1][2], vn[2 * kt + 1][3]));
#pragma unroll
        for (int m = 0; m < 4; ++m)
#pragma unroll
            for (int kt = 0; kt < 2; ++kt) o[m] = mfma16(lds_a2(buf + SB_QK, 144, 16 * m + fr, 32 * kt, fq), vb[kt], o[m]);
#pragma unroll
        for (int m8 = 0; m8 < 8; ++m8) {
            S[m8] = S[m8] * eg;
#pragma unroll
            for (int kt = 0; kt < 2; ++kt) S[m8] = mfma16(lds_a2(buf + SB_KDT, 144, 16 * m8 + fr, 32 * kt, fq), vb[kt], S[m8]);
            asm volatile("" ::: "memory");
        }
        LAS bf16_t* OB = (LAS bf16_t*)(lds + SB_SSQ);
#pragma unroll
        for (int m = 0; m < 4; ++m)
#pragma unroll
            for (int j = 0; j < 4; ++j) OB[(16 * m + 4 * fq + j) * 136 + dv] = f2bf(o[m][j]);
        if (has_next) scan_store(lds + ((step + 1) & 1) * SB_BYTES, tid, st);
        lds_barrier();
        {
            const u32x4 oa = *(const LAS u32x4*)(OB + ztok * 136 + zc0), ob = *(const LAS u32x4*)(OB + ztok * 136 + zc0 + 8);
            float ov[16], zz[16];
            ov[0] = bflo(oa.x); ov[1] = bfhi(oa.x); ov[2] = bflo(oa.y); ov[3] = bfhi(oa.y); ov[4] = bflo(oa.z); ov[5] = bfhi(oa.z); ov[6] = bflo(oa.w); ov[7] = bfhi(oa.w);
            ov[8] = bflo(ob.x); ov[9] = bfhi(ob.x); ov[10] = bflo(ob.y); ov[11] = bfhi(ob.y); ov[12] = bflo(ob.z); ov[13] = bfhi(ob.z); ov[14] = bflo(ob.w); ov[15] = bfhi(ob.w);
            zz[0] = bflo(za.x); zz[1] = bfhi(za.x); zz[2] = bflo(za.y); zz[3] = bfhi(za.y); zz[4] = bflo(za.z); zz[5] = bfhi(za.z); zz[6] = bflo(za.w); zz[7] = bfhi(za.w);
            zz[8] = bflo(zb.x); zz[9] = bfhi(zb.x); zz[10] = bflo(zb.y); zz[11] = bfhi(zb.y); zz[12] = bflo(zb.z); zz[13] = bfhi(zb.z); zz[14] = bflo(zb.w); zz[15] = bfhi(zb.w);
            float ss = 0.f;
#pragma unroll
            for (int i = 0; i < 16; ++i) ss += ov[i] * ov[i];
            ss += __shfl_xor(ss, 1); ss += __shfl_xor(ss, 2); ss += __shfl_xor(ss, 4);
            const float rstd = rsqrtf(ss * (1.f / 128.f) + 1e-6f);
#pragma unroll
            for (int q = 0; q < 4; ++q) { const f32x4 w4 = nw4[q];
#pragma unroll
                for (int e = 0; e < 4; ++e) { const float z = zz[4 * q + e]; ov[4 * q + e] = ov[4 * q + e] * rstd * w4[e] * (z * sigmoidf_(z)); } }
            if (ztok < nvalid) {
                u32x4 wa, wb;
                wa.x = pk(ov[0], ov[1]); wa.y = pk(ov[2], ov[3]); wa.z = pk(ov[4], ov[5]); wa.w = pk(ov[6], ov[7]);
                wb.x = pk(ov[8], ov[9]); wb.y = pk(ov[10], ov[11]); wb.z = pk(ov[12], ov[13]); wb.w = pk(ov[14], ov[15]);
                bf16_t* op = zp + (C_GV - C_Z); *(u32x4*)op = wa; *(u32x4*)(op + 8) = wb;
            }
        }
        lds_barrier();
#pragma unroll
        for (int m = 0; m < 4; ++m) ut[m] = utn[m];
        eg = egn;
    }
    float* so = C.out + (sample ? O_SGS + (((size_t)l * 32 + bidx) * 4 + h) * 16384 : O_PGS + (((size_t)l * 16 + bidx) * 4 + h) * 16384);
#pragma unroll
    for (int m = 0; m < 8; ++m)
#pragma unroll
        for (int j = 0; j < 4; ++j) so[(16 * m + 4 * fq + j) * 128 + dv] = S[m][j];
    lds_barrier();
}

constexpr int AT_KS = 0, AT_VT = 69632, AT_Q = 144000;
template <int D, int MQ>
DI void attn_loadq(const bf16_t* q0, const bf16_t* q1, int ldq, int lane, bf16x8 (&qf)[MQ][D / 32]) {
    const int fr = lane & 15, fq = lane >> 4;
#pragma unroll
    for (int mq = 0; mq < MQ; ++mq)
#pragma unroll
        for (int ks = 0; ks < D / 32; ++ks) qf[mq][ks] = *(const bf16x8*)((mq ? q1 : q0) + (size_t)fr * ldq + ks * 32 + fq * 8);
}
template <int D, int NT, int MQ>
DI void attn_core(const LAS unsigned char* Ks, const LAS unsigned char* VTs, const bf16x8 (&qf)[MQ][D / 32], bf16_t* o0, bf16_t* o1, int ldo,
                  int kmax, bool has_sink, float sink0, float sink1, float scale, int lane) {
    const int fr = lane & 15, fq = lane >> 4;
    constexpr int KS = D / 32, ND = D / 16, KST = (D + 8) * 2, VST = (NT * 16 + 8) * 2;
    f32x4 s[MQ][NT];
#pragma unroll
    for (int t = 0; t < NT; ++t) {
        bf16x8 kf[KS];
#pragma unroll
        for (int ks = 0; ks < KS; ++ks) kf[ks] = *(const LAS bf16x8*)(Ks + (16 * t + fr) * KST + (32 * ks + 8 * fq) * 2);
#pragma unroll
        for (int mq = 0; mq < MQ; ++mq) { f32x4 a = {0.f, 0.f, 0.f, 0.f};
#pragma unroll
            for (int ks = 0; ks < KS; ++ks) a = mfma16(kf[ks], qf[mq][ks], a);
            s[mq][t] = a; }
        if (t & 1) asm volatile("" ::: "memory");
    }
    unsigned pkd[MQ][NT][2];
#pragma unroll
    for (int mq = 0; mq < MQ; ++mq) {
        const float sink = mq ? sink1 : sink0;
        float mx = has_sink ? sink : -INFINITY;
#pragma unroll
        for (int t = 0; t < NT; ++t)
#pragma unroll
            for (int j = 0; j < 4; ++j) { const int key = 16 * t + 4 * fq + j; const float v = (key < kmax) ? s[mq][t][j] * scale : -INFINITY; s[mq][t][j] = v; mx = fmaxf(mx, v); }
        mx = fmaxf(mx, __shfl_xor(mx, 16)); mx = fmaxf(mx, __shfl_xor(mx, 32));
        float sum = 0.f;
#pragma unroll
        for (int t = 0; t < NT; ++t)
#pragma unroll
            for (int j = 0; j < 4; ++j) { const float p = __expf(s[mq][t][j] - mx); s[mq][t][j] = p; sum += p; }
        sum += __shfl_xor(sum, 16); sum += __shfl_xor(sum, 32);
        if (has_sink) sum += __expf(sink - mx);
        const float inv = 1.f / sum;
#pragma unroll
        for (int t = 0; t < NT; ++t) { pkd[mq][t][0] = pk(s[mq][t][0] * inv, s[mq][t][1] * inv); pkd[mq][t][1] = pk(s[mq][t][2] * inv, s[mq][t][3] * inv); }
    }
    f32x4 o[MQ][ND];
#pragma unroll
    for (int mq = 0; mq < MQ; ++mq)
#pragma unroll
        for (int n = 0; n < ND; ++n) o[mq][n] = (f32x4){0.f, 0.f, 0.f, 0.f};
#pragma unroll
    for (int s2 = 0; s2 < NT / 2; ++s2) {
        bf16x8 pf[MQ];
#pragma unroll
        for (int mq = 0; mq < MQ; ++mq) pf[mq] = mk8(pkd[mq][2 * s2][0], pkd[mq][2 * s2][1], pkd[mq][2 * s2 + 1][0], pkd[mq][2 * s2 + 1][1]);
#pragma unroll
        for (int n = 0; n < ND; ++n) {
            const LAS unsigned char* p = VTs + (16 * n + fr) * VST + (32 * s2 + 4 * fq) * 2;
            const u32x2 lo = *(const LAS u32x2*)p, hi = *(const LAS u32x2*)(p + 32);
            const bf16x8 vf = mk8(lo.x, lo.y, hi.x, hi.y);
#pragma unroll
            for (int mq = 0; mq < MQ; ++mq) o[mq][n] = mfma16(vf, pf[mq], o[mq][n]);
            if ((n & 3) == 3) asm volatile("" ::: "memory");
        }
    }
#pragma unroll
    for (int mq = 0; mq < MQ; ++mq)
#pragma unroll
        for (int n = 0; n < ND; ++n) { u32x2 w; w.x = pk(o[mq][n][0], o[mq][n][1]); w.y = pk(o[mq][n][2], o[mq][n][3]);
            *(u32x2*)((mq ? o1 : o0) + (size_t)fr * ldo + 16 * n + 4 * fq) = w; }
}
template <int D, int NT>
DI void attn_stage(LAS unsigned char* Ks, LAS unsigned char* VTs, const bf16_t* kb, const bf16_t* vb, int ldk, int nrows, int row_off, int tid) {
    constexpr int KST = (D + 8) * 2, VST = (NT * 16 + 8) * 2, PR = D / 8;
    const int total = nrows * PR;
    for (int p = tid; p < total; p += NTHR) { const int r = p / PR, c = p % PR;
        const u32x4 kv = *(const u32x4*)(kb + (size_t)r * ldk + c * 8), vv = *(const u32x4*)(vb + (size_t)r * ldk + c * 8);
        *(LAS u32x4*)(Ks + (row_off + r) * KST + c * 16) = kv;
        LAS bf16_t* vt = (LAS bf16_t*)(VTs + (c * 8) * VST + (row_off + r) * 2);
        vt[0] = (bf16_t)(vv.x & 0xffffu); vt[VST / 2] = (bf16_t)(vv.x >> 16); vt[2 * (VST / 2)] = (bf16_t)(vv.y & 0xffffu); vt[3 * (VST / 2)] = (bf16_t)(vv.y >> 16);
        vt[4 * (VST / 2)] = (bf16_t)(vv.z & 0xffffu); vt[5 * (VST / 2)] = (bf16_t)(vv.z >> 16); vt[6 * (VST / 2)] = (bf16_t)(vv.w & 0xffffu); vt[7 * (VST / 2)] = (bf16_t)(vv.w >> 16); }
}
template <int D, int NT>
DI void attn_zero_vt(LAS unsigned char* VTs, int k0, int tid) {
    constexpr int VST = (NT * 16 + 8) * 2; const int w = NT * 16 - k0;
    for (int p = tid; p < D * w; p += NTHR) { const int d = p / w, k = k0 + p % w; *(LAS bf16_t*)(VTs + d * VST + k * 2) = 0; }
}

constexpr int NC_XAP = 64 * 8, NC_SWP = 16 * 64 * 2, NC_SWS = 32 * 2, NC_XAS = 32 * 4, NC_TOTAL = NC_XAP + NC_SWP + NC_SWS + NC_XAS;

DI void attn_phase(LAS unsigned char* lds, const Ctx& C, int l) {
    int tid_ = threadIdx.x; asm volatile("" : "+v"(tid_));
    const int tid = tid_, lane = tid & 63, wid = __builtin_amdgcn_readfirstlane(tid >> 6);
    const int nw = C.G > 64 ? C.G - 64 : C.G, me = C.G > 64 ? C.c - 64 : C.c;
    if (me < 0) return;
    bf16_t* H = (bf16_t*)(C.ws + WS_H);
    const bf16_t* MK = (const bf16_t*)(C.ws + WS_MKV + (size_t)l * MKV_L);
    LAS unsigned char* Ks = lds + AT_KS; LAS unsigned char* VTs = lds + AT_VT;
    {
        const int lo = (int)((long)me * 2048 / nw), hi = (int)((long)(me + 1) * 2048 / nw);
        int staged = -1;
        bf16x8 qf[1][4], qn[1][4];
        if (lo < hi) { const int pair = lo >> 5; const bf16_t* q0 = H + (size_t)((pair >> 2) * 4096 + (lo & 31) * 128 + wid * 16) * HLD + C_XQ + (pair & 3) * 128; attn_loadq<128, 1>(q0, q0, HLD, lane, qf); }
#pragma unroll 1
        for (int blk = lo; blk < hi; ++blk) {
            const int pair = blk >> 5, b = pair >> 2, hd = pair & 3;
            if (staged != pair) { __syncthreads(); const bf16_t* kb = MK + (size_t)(b * 256) * 1024 + hd * 128; attn_stage<128, 16>(Ks, VTs, kb, kb + 512, 1024, 256, 0, tid); staged = pair; __syncthreads(); }
            const int row0 = b * 4096 + (blk & 31) * 128 + wid * 16;
            bf16_t* q0 = H + (size_t)row0 * HLD + C_XQ + hd * 128;
            { const int nb = blk + 1 < hi ? blk + 1 : blk; const int np = nb >> 5; const bf16_t* qx = H + (size_t)((np >> 2) * 4096 + (nb & 31) * 128 + wid * 16) * HLD + C_XQ + (np & 3) * 128; attn_loadq<128, 1>(qx, qx, HLD, lane, qn); }
            attn_core<128, 16, 1>(Ks, VTs, qf, q0 + (C_GK - C_XQ), q0 + (C_GK - C_XQ), HLD, 256, false, 0.f, 0.f, 0.08838834764831845f, lane);
#pragma unroll
            for (int ks = 0; ks < 4; ++ks) qf[0][ks] = qn[0][ks];
        }
    }
#pragma unroll 1
    for (int ch = me; ch < NC_SWP; ch += nw) {
        const int g = ch & 1, n = (ch >> 1) & 63, b = ch >> 7;
        const int nk = (n >= 2 ? 3 : n + 1) * 64; const int r0 = b * 4096 + (n >= 2 ? n - 2 : 0) * 64;
        const int tb = wid >> 1, hp = wid & 1, hq0 = g * 4 + hp * 2;
        bf16_t* q0 = H + (size_t)(b * 4096 + n * 64 + tb * 16) * HLD + C_SQ + hq0 * 64;
        bf16x8 qs[2][2]; attn_loadq<64, 2>(q0, q0 + 64, HLD, lane, qs);
        const float sk0 = C.sinks[l * 8 + hq0], sk1 = C.sinks[l * 8 + hq0 + 1];
        __syncthreads();
        attn_stage<64, 12>(Ks, VTs, H + (size_t)r0 * HLD + C_SK + g * 64, H + (size_t)r0 * HLD + C_SV + g * 64, HLD, nk, 0, tid);
        if (nk < 192) attn_zero_vt<64, 12>(VTs, nk, tid);
        __syncthreads();
        attn_core<64, 12, 2>(Ks, VTs, qs, q0 + (C_GQ - C_SQ), q0 + 64 + (C_GQ - C_SQ), HLD, nk, true, sk0, sk1, 0.125f, lane);
    }
#pragma unroll 1
    for (int ch0 = me; ch0 < NC_SWS + NC_XAS; ch0 += nw) {
        __syncthreads();
        if (ch0 < NC_SWS) {
            const int g = ch0 & 1, sb = ch0 >> 1; const int row0 = NP + sb * 16;
            const bf16_t* sw = (const bf16_t*)(C.ws + WS_SWC + (size_t)l * SWC_L) + (size_t)(sb * 128) * 256;
            attn_stage<64, 10>(Ks, VTs, sw + g * 64, sw + 128 + g * 64, 256, 128, 0, tid);
            attn_stage<64, 10>(Ks, VTs, H + (size_t)row0 * HLD + C_SK + g * 64, H + (size_t)row0 * HLD + C_SV + g * 64, HLD, 16, 128, tid);
            attn_zero_vt<64, 10>(VTs, 144, tid);
            __syncthreads();
            if (wid < 2) { const int hq0 = g * 4 + wid * 2;
                bf16_t* q0 = H + (size_t)row0 * HLD + C_SQ + hq0 * 64;
                bf16x8 qs[2][2]; attn_loadq<64, 2>(q0, q0 + 64, HLD, lane, qs);
                attn_core<64, 10, 2>(Ks, VTs, qs, q0 + (C_GQ - C_SQ), q0 + 64 + (C_GQ - C_SQ), HLD, 144, true, C.sinks[l * 8 + hq0], C.sinks[l * 8 + hq0 + 1], 0.125f, lane); }
        } else {
            const int ch = ch0 - NC_SWS; const int hd = ch & 3, sb = ch >> 2; const int row0 = NP + sb * 16;
            const bf16_t* kb = MK + (size_t)(4096 + sb * 256) * 1024 + hd * 128;
            attn_stage<128, 16>(Ks, VTs, kb, kb + 512, 1024, 256, 0, tid);
            __syncthreads();
            if (wid == 0) { bf16_t* q0 = H + (size_t)row0 * HLD + C_XQ + hd * 128;
                bf16x8 qx[1][4]; attn_loadq<128, 1>(q0, q0, HLD, lane, qx);
                attn_core<128, 16, 1>(Ks, VTs, qx, q0 + (C_GK - C_XQ), q0 + (C_GK - C_XQ), HLD, 256, false, 0.f, 0.f, 0.08838834764831845f, lane); }
        }
    }
    __syncthreads();
}

#define XB_TMO      128
#define XB_XCNT(j)  (256  + 64 * (j))
#define XB_XSUB(j)  (1280 + 64 * (j))
#define XB_XGEN(j)  (2304 + 64 * (j))
#define XB_TOP      3328
#define XB_TOPGEN   3392
#define XCD_BAR_WORDS 3456
#define XB_SPIN_CAP (1u << 20)
DI unsigned xb_ld(unsigned* p)              { return __hip_atomic_load(p, __ATOMIC_RELAXED, __HIP_MEMORY_SCOPE_AGENT); }
DI unsigned xb_add(unsigned* p, unsigned v) { return __hip_atomic_fetch_add(p, v, __ATOMIC_RELAXED, __HIP_MEMORY_SCOPE_AGENT); }
DI unsigned xb_xcc_id() { return (unsigned)__builtin_amdgcn_s_getreg((3 << 11) | 20) & 0xFu; }
#define XB_SPIN(cond, bar) do { unsigned _sp = 0; while (cond) { __builtin_amdgcn_s_sleep(1); \
    if ((++_sp & 255u) == 0u) { if (xb_ld(&(bar)[XB_TMO])) break; if (_sp > XB_SPIN_CAP) { atomicAdd(&(bar)[XB_TMO], 1u); break; } } } } while (0)
struct XcdBarrier { unsigned* bar; unsigned x; volatile LAS unsigned* st; };
DI XcdBarrier xcd_barrier_post(unsigned* bar, volatile LAS unsigned* st) {
    XcdBarrier b; b.bar = bar; b.x = xb_xcc_id(); b.st = st;
    if (threadIdx.x == 0) (void)xb_add(&bar[XB_XCNT(b.x)], 1u);
    return b;
}
DI void xcd_barrier_complete(unsigned* bar, unsigned x, unsigned& nloc, unsigned& nx) {
    const unsigned G = gridDim.x * gridDim.y * gridDim.z;
    unsigned sum, cnt, mine, sp = 0u;
    for (;;) {
        sum = 0u; cnt = 0u; mine = 0u;
#pragma unroll
        for (unsigned j = 0; j < 16; ++j) { const unsigned c = xb_ld(&bar[XB_XCNT(j)]); sum += c; cnt += (c > 0u) ? 1u : 0u; mine = (j == x) ? c : mine; }
        if (sum == G) break;
        __builtin_amdgcn_s_sleep(1);
        if ((++sp & 255u) == 0u) { if (xb_ld(&bar[XB_TMO])) break; if (sp > XB_SPIN_CAP) { atomicAdd(&bar[XB_TMO], 1u); break; } }
    }
    nloc = mine > 0u ? mine : 1u; nx = cnt > 0u ? cnt : 1u;
}
DI void xcd_barrier(const XcdBarrier& b) {
    asm volatile("s_waitcnt vmcnt(0)" ::: "memory");
    __syncthreads();
    if (threadIdx.x == 0) {
        unsigned* bar = b.bar;
        __builtin_amdgcn_s_waitcnt(0);
        unsigned nloc = b.st[0], nx = b.st[1];
        if (nloc == 0u) { xcd_barrier_complete(bar, b.x, nloc, nx); b.st[0] = nloc; b.st[1] = nx; }
        const unsigned old = xb_add(&bar[XB_XSUB(b.x)], 1u);
        const unsigned gen = old / nloc;
        if (old + 1u == (gen + 1u) * nloc) {
            __builtin_amdgcn_fence(__ATOMIC_RELEASE, "agent");
            asm volatile("s_waitcnt vmcnt(0)" ::: "memory");
            const unsigned og = xb_add(&bar[XB_TOP], 1u);
            const unsigned tg = og / nx;
            if (og + 1u == (tg + 1u) * nx) xb_add(&bar[XB_TOPGEN], 1u);
            else XB_SPIN(xb_ld(&bar[XB_TOPGEN]) == tg, bar);
            __builtin_amdgcn_fence(__ATOMIC_ACQUIRE, "agent");
            xb_add(&bar[XB_XGEN(b.x)], 1u);
            asm volatile("s_waitcnt vmcnt(0)" ::: "memory");
        } else {
            XB_SPIN(xb_ld(&bar[XB_XGEN(b.x)]) == gen, bar);
            __builtin_amdgcn_fence(__ATOMIC_ACQUIRE, "agent");
            asm volatile("s_waitcnt vmcnt(0)" ::: "memory");
        }
    }
    __syncthreads();
}

__global__ void __launch_bounds__(NTHR, 2) hybrid_fwd(Params P) {
    extern __shared__ __attribute__((aligned(16))) unsigned char lds_raw[];
    LAS unsigned char* lds = (LAS unsigned char*)lds_raw;
    cg::grid_group grid = cg::this_grid();
    Ctx C;
    C.xp = P.in[0]; C.xs = P.in[1]; C.st_s = P.in[2]; C.st_conv = P.in[3]; C.csk = P.in[4]; C.csv = P.in[5]; C.cmk = P.in[6]; C.cmv = P.in[7]; C.memp = P.in[8];
    C.w_in = P.in[9]; C.conv_w = P.in[10]; C.a_log = P.in[11]; C.dt_bias = P.in[12]; C.gnw = P.in[13]; C.sinks = P.in[14]; C.w_mkv = P.in[15]; C.w_br = P.in[16]; C.w_o = P.in[17];
    C.ln1g = P.in[18]; C.ln1b = P.in[19]; C.w_up = P.in[20]; C.w_dn = P.in[21]; C.ln2g = P.in[22]; C.ln2b = P.in[23];
    C.out = P.out; C.ws = P.ws; C.G = gridDim.x; C.c = blockIdx.x; C.panel = 0;
    const int lo = P.ph_lo, hi = P.ph_hi;
    volatile LAS unsigned* xst = (volatile LAS unsigned*)(lds + 147440);
    if (threadIdx.x < 2) xst[threadIdx.x] = 0u;
    __syncthreads();
    const XcdBarrier xbar = xcd_barrier_post((unsigned*)(C.ws + WS_CTL) + 4096, xst);
#define RUN(ph) ((ph) >= lo && (ph) < hi)
#define SYNC(ph) do { if (RUN(ph) && RUN((ph) + 1)) { if ((ph) == 0) grid.sync(); else xcd_barrier(xbar); } } while (0)
    if (RUN(0)) p0_convert(lds, C);
    SYNC(0);
#pragma unroll 1
    for (int l = 0; l < 2; ++l) {
        const int pb = 1 + l * 9;
        if (RUN(pb + 0)) { gemm_phase<PH_H>(lds, C, l); gemm_phase<PH_MKV>(lds, C, l); }
        SYNC(pb + 0);
        if (RUN(pb + 1)) { state_copies(C, l); for (int it = C.c; it < N_GITEMS / 2; it += C.G) gdn_pre_pair(lds, C, l, it); }
        SYNC(pb + 1);
        if (RUN(pb + 2)) { for (int it = C.c; it < 192; it += C.G) gdn_scan_item(lds, C, l, it); attn_phase(lds, C, l); gemm_phase<PH_GATE>(lds, C, l); }
        SYNC(pb + 2);
        if (RUN(pb + 3)) { gemm_phase<PH_MERGE>(lds, C, l); gemm_phase<PH_MERGES>(lds, C, l); xcd_barrier(xbar); merge_fixup(C); }
        SYNC(pb + 3);
        if (RUN(pb + 4)) { gemm_phase<PH_WO>(lds, C, l); gemm_phase<PH_WOS>(lds, C, l); }
        SYNC(pb + 4);
        if (RUN(pb + 5)) { ln_phase(C, C.ln1g + l * 1024, C.ln1b + l * 1024, false); ln_sample(C, 4, C.ln1g + l * 1024, C.ln1b + l * 1024, false); }
        SYNC(pb + 5);
        if (RUN(pb + 6)) gemm_phase<PH_UP>(lds, C, l);
        SYNC(pb + 6);
        if (RUN(pb + 7)) { gemm_phase<PH_DN>(lds, C, l); gemm_phase<PH_DNS>(lds, C, l); }
        SYNC(pb + 7);
        if (RUN(pb + 8)) { ln_phase(C, C.ln2g + l * 1024, C.ln2b + l * 1024, l == 1); ln_sample(C, 16, C.ln2g + l * 1024, C.ln2b + l * 1024, l == 1); }
        SYNC(pb + 8);
    }
#undef RUN
#undef SYNC
}

extern "C" void kernel_launch(void* const* d_in, const int* in_sizes, int n_in, void* d_out, int out_size, void* d_ws, size_t ws_size, hipStream_t stream) {
    static int grid = 0;
    if (grid == 0) {
        if (n_in != 24 || ws_size < WS_NEED) { fprintf(stderr, "kernel_launch: unexpected n_in %d / ws %zu\n", n_in, ws_size); grid = -1; return; }
        int dev = 0, cus = 0, per_cu = 0;
        hipGetDevice(&dev); hipDeviceGetAttribute(&cus, hipDeviceAttributeMultiprocessorCount, dev);
        if (hipFuncSetAttribute((const void*)hybrid_fwd, hipFuncAttributeMaxDynamicSharedMemorySize, LDS_BYTES) != hipSuccess) { fprintf(stderr, "hipFuncSetAttribute failed\n"); grid = -1; return; }
        if (hipOccupancyMaxActiveBlocksPerMultiprocessor(&per_cu, (const void*)hybrid_fwd, NTHR, LDS_BYTES) != hipSuccess || per_cu < 1) { fprintf(stderr, "occupancy query: %d\n", per_cu); per_cu = 1; }
        (void)hipGetLastError();
        grid = cus * per_cu;
    }
    if (grid < 0) return;
    (void)hipMemsetAsync((char*)d_ws + WS_CTL, 0, 32768, stream);
    Params p{};
    for (int i = 0; i < 24; ++i) p.in[i] = (const float*)d_in[i];
    p.out = (float*)d_out; p.ws = (unsigned char*)d_ws; p.ph_lo = 0; p.ph_hi = 19;
    void* args[] = {&p};
    hipError_t e = hipLaunchCooperativeKernel((const void*)hybrid_fwd, dim3(grid), dim3(NTHR), args, LDS_BYTES, stream);
    if (e != hipSuccess) fprintf(stderr, "cooperative launch failed: %s (grid %d)\n", hipGetErrorString(e), grid);
}
```
